# Optimizing an MI355X kernel written in HIP

```python
import math
import jax, jax.numpy as jnp
from jax import lax
import numpy as np

D_MODEL = 2048
BATCH = 4
SEQ = 4096
DEPTH = 4

GRID_W = 64
CTX_LEN = 256
N_MIXERS = 2
HEAD_DIM = 128
N_HEADS = D_MODEL // HEAD_DIM
N_KV_HEADS = 4
WINDOW = 128
BLOCK = WINDOW
ROPE_BASE = 10000.0
D_RNN = ((4 * D_MODEL // 3 + 255) // 256) * 256
RNN_BLOCKS = 16
RNN_BW = D_RNN // RNN_BLOCKS
CONV_W = 4
CONV_LEFT = CONV_W // 2
RG_C = 8.0
FFN_HIDDEN = ((8 * D_MODEL // 3 + 255) // 256) * 256
N_REC_LAYERS = (DEPTH + 1) // 2
N_ATT_LAYERS = DEPTH // 2
LN_EPS = 1e-5
NEG_INF = -1e30
MOD_INIT = 0.5

kernel_name = 'hybrid_rglru_swa_deepnorm_prefix_ctx'


def layer_norm(h, g, b):
    hf = h.astype(jnp.float32)
    mu = hf.mean(-1, keepdims=True)
    var = jnp.square(hf - mu).mean(-1, keepdims=True)
    return ((hf - mu) * lax.rsqrt(var + LN_EPS) * g + b).astype(h.dtype)


def modulate(h, shift, scale):
    return h * (1.0 + scale) + shift


def swiglu(u, w_gate, w_up, w_down):
    return (jax.nn.silu(u @ w_gate) * (u @ w_up)) @ w_down


def axial_rope_tables(n_tokens):
    rows = n_tokens // GRID_W
    row = jnp.repeat(jnp.arange(rows, dtype=jnp.float32), GRID_W)
    col = jnp.tile(jnp.arange(GRID_W, dtype=jnp.float32), rows)
    axis_dim = HEAD_DIM // 2
    inv_freq = ROPE_BASE ** (-jnp.arange(0, axis_dim, 2, dtype=jnp.float32) / axis_dim)
    ang = jnp.concatenate([row[:, None] * inv_freq, col[:, None] * inv_freq], axis=-1)
    return jnp.cos(ang), jnp.sin(ang)


def apply_rope(t, cos, sin):
    half = t.shape[-1] // 2
    t1, t2 = t[..., :half], t[..., half:]
    c, s = cos[:, None, :], sin[:, None, :]
    return jnp.concatenate([t1 * c - t2 * s, t2 * c + t1 * s], axis=-1).astype(t.dtype)


def sink_softmax(scores, sink):
    m = sink
    for s in scores:
        m = jnp.maximum(m, s.max(-1, keepdims=True))
    ps = [jnp.exp(s - m) for s in scores]
    denom = jnp.exp(sink - m) + sum(p.sum(-1, keepdims=True) for p in ps)
    return [p / denom for p in ps]


def windowed_latent_attention(q, k, v, kc, vc, sink):
    B, S, H, Dh = q.shape
    NB = S // BLOCK
    G = H // N_KV_HEADS
    scale = Dh ** -0.5
    qb = q.reshape(B, NB, BLOCK, N_KV_HEADS, G, Dh)

    def band(t):
        tp = jnp.pad(t, ((0, 0), (BLOCK, BLOCK), (0, 0), (0, 0)))
        return jnp.concatenate([tp[:, o * BLOCK:o * BLOCK + S].reshape(B, NB, BLOCK, N_KV_HEADS, Dh) for o in range(3)], axis=2)

    kb, vb = band(k), band(v)
    qi = jnp.arange(BLOCK)[:, None]
    si = jnp.arange(3 * BLOCK)[None, :]
    in_window = jnp.abs(si - BLOCK - qi) <= WINDOW
    key_pos = jnp.arange(NB)[:, None] * BLOCK - BLOCK + jnp.arange(3 * BLOCK)[None, :]
    in_range = (key_pos >= 0) & (key_pos < S)
    mask = in_window[None] & in_range[:, None, :]
    s_loc = jnp.einsum('bnqkgd,bnskd->bnkgqs', qb, kb).astype(jnp.float32) * scale
    s_loc = jnp.where(mask[None, :, None, None], s_loc, NEG_INF)
    s_ctx = jnp.einsum('bnqkgd,bckd->bnkgqc', qb, kc).astype(jnp.float32) * scale
    sink_b = sink.astype(jnp.float32).reshape(1, 1, N_KV_HEADS, G, 1, 1)
    p_loc, p_ctx = sink_softmax([s_loc, s_ctx], sink_b)
    o = (jnp.einsum('bnkgqs,bnskd->bnqkgd', p_loc.astype(v.dtype), vb)
         + jnp.einsum('bnkgqc,bckd->bnqkgd', p_ctx.astype(v.dtype), vc))
    return o.reshape(B, S, H * Dh)


def context_attention(qc, kc, vc, sink):
    B, C, H, Dh = qc.shape
    G = H // N_KV_HEADS
    qg = qc.reshape(B, C, N_KV_HEADS, G, Dh)
    s = jnp.einsum('bqkgd,bskd->bkgqs', qg, kc).astype(jnp.float32) * (Dh ** -0.5)
    (p,) = sink_softmax([s], sink.astype(jnp.float32).reshape(1, N_KV_HEADS, G, 1, 1))
    o = jnp.einsum('bkgqs,bskd->bqkgd', p.astype(vc.dtype), vc)
    return o.reshape(B, C, H * Dh)


def attention_mixer(uc, ux, w_qkv, sink, w_o, cos, sin, ctx_out):
    B, S, _ = ux.shape
    C = uc.shape[1]
    nq = N_HEADS * HEAD_DIM
    nkv = N_KV_HEADS * HEAD_DIM
    qkv = ux @ w_qkv
    q = apply_rope(qkv[..., :nq].reshape(B, S, N_HEADS, HEAD_DIM), cos, sin)
    k = apply_rope(qkv[..., nq:nq + nkv].reshape(B, S, N_KV_HEADS, HEAD_DIM), cos, sin)
    v = qkv[..., nq + nkv:].reshape(B, S, N_KV_HEADS, HEAD_DIM)
    if ctx_out:
        qkv_c = uc @ w_qkv
        qc = qkv_c[..., :nq].reshape(B, C, N_HEADS, HEAD_DIM)
        kvc = qkv_c[..., nq:]
    else:
        kvc = uc @ w_qkv[:, nq:]
    kc = kvc[..., :nkv].reshape(B, C, N_KV_HEADS, HEAD_DIM)
    vc = kvc[..., nkv:].reshape(B, C, N_KV_HEADS, HEAD_DIM)
    out_x = windowed_latent_attention(q, k, v, kc, vc, sink) @ w_o
    if not ctx_out:
        return None, out_x
    out_c = context_attention(qc, kc, vc, sink) @ w_o
    return out_c, out_x


def centred_dwconv(z, w, b):
    L = z.shape[1]
    zp = jnp.pad(z, ((0, 0), (CONV_LEFT, CONV_W - 1 - CONV_LEFT), (0, 0)))
    return sum(zp[:, j:j + L] * w[j] for j in range(CONV_W)) + b


def rglru_coeffs(z, wa, ba, wx, bx, lam):
    B, L, _ = z.shape
    zb = z.reshape(B, L, RNN_BLOCKS, RNN_BW)
    r = jax.nn.sigmoid((jnp.einsum('blhi,hij->blhj', zb, wa).reshape(B, L, D_RNN) + ba).astype(jnp.float32))
    ig = jax.nn.sigmoid((jnp.einsum('blhi,hij->blhj', zb, wx).reshape(B, L, D_RNN) + bx).astype(jnp.float32))
    log_a = -RG_C * r * jax.nn.softplus(-lam.astype(jnp.float32))
    a = jnp.exp(log_a)
    b = jnp.sqrt(-jnp.expm1(2.0 * log_a)) * ig * z.astype(jnp.float32)
    return a, b


def _linear_combine(left, right):
    a_l, b_l = left
    a_r, b_r = right
    return a_l * a_r, a_r * b_l + b_r


def linear_scan(a, b, h0, reverse):
    if h0 is not None:
        edge = -1 if reverse else 0
        b = b.at[:, edge].add(a[:, edge] * h0)
    return lax.associative_scan(_linear_combine, (a, b), reverse=reverse, axis=1)[1]


def recurrent_mixer(uc, ux, w_in, conv_w, conv_b, ga_w, ga_b, gx_w, gx_b, lam, w_out, ctx_out):
    px = ux @ w_in
    yx = jax.nn.gelu(px[..., :D_RNN])
    zx = centred_dwconv(px[..., D_RNN:], conv_w, conv_b)
    if ctx_out:
        pc = uc @ w_in
        yc = jax.nn.gelu(pc[..., :D_RNN])
        zc = centred_dwconv(pc[..., D_RNN:], conv_w, conv_b)
    else:
        zc = centred_dwconv(uc @ w_in[:, D_RNN:], conv_w, conv_b)
    hx = 0.0
    hc = 0.0
    for d, reverse in enumerate((False, True)):
        ac, bc = rglru_coeffs(zc, ga_w[d], ga_b[d], gx_w[d], gx_b[d], lam[d])
        h_ctx = linear_scan(ac, bc, None, reverse)
        h_end = h_ctx[:, 0] if reverse else h_ctx[:, -1]
        ax, bx_ = rglru_coeffs(zx, ga_w[d], ga_b[d], gx_w[d], gx_b[d], lam[d])
        hx = hx + linear_scan(ax, bx_, h_end, reverse)
        if ctx_out:
            hc = hc + h_ctx
    out_x = (yx * hx.astype(yx.dtype)) @ w_out
    if not ctx_out:
        return None, out_x
    out_c = (yc * hc.astype(yc.dtype)) @ w_out
    return out_c, out_x


def setup_inputs(seed: int = 0) -> dict:
    key = jax.random.key(seed)
    ks = iter(jax.random.split(key, 32))
    f32 = jnp.float32

    def nrm(shape, scale):
        return jax.random.normal(next(ks), shape, f32) * scale

    beta = (8.0 * DEPTH) ** -0.25
    D = D_MODEL
    u = jax.random.uniform(next(ks), (N_REC_LAYERS, 2, D_RNN), f32, minval=0.9, maxval=0.999)
    return {
        'x': nrm((BATCH, SEQ, D), 1.0),
        'c': nrm((BATCH, D), 1.0),
        'ctx': nrm((BATCH, CTX_LEN, D), 1.0),
        'c_ctx': nrm((D,), 1.0),
        'mod_w': nrm((DEPTH, D, 6 * D), MOD_INIT * D ** -0.5),
        'mod_b': nrm((DEPTH, 6 * D), 0.02),
        'ln_mix_g': 1.0 + nrm((DEPTH, D), 0.02),
        'ln_mix_b': nrm((DEPTH, D), 0.02),
        'ln_ffn_g': 1.0 + nrm((DEPTH, D), 0.02),
        'ln_ffn_b': nrm((DEPTH, D), 0.02),
        'ffn_w_gate': nrm((DEPTH, D, FFN_HIDDEN), D ** -0.5),
        'ffn_w_up': nrm((DEPTH, D, FFN_HIDDEN), D ** -0.5),
        'ffn_w_down': nrm((DEPTH, FFN_HIDDEN, D), beta * FFN_HIDDEN ** -0.5),
        'rec_w_in': nrm((N_REC_LAYERS, D, 2 * D_RNN), D ** -0.5),
        'rec_conv_w': nrm((N_REC_LAYERS, CONV_W, D_RNN), CONV_W ** -0.5),
        'rec_conv_b': nrm((N_REC_LAYERS, D_RNN), 0.02),
        'rec_gate_a_w': nrm((N_REC_LAYERS, 2, RNN_BLOCKS, RNN_BW, RNN_BW), RNN_BW ** -0.5),
        'rec_gate_a_b': nrm((N_REC_LAYERS, 2, D_RNN), 0.02),
        'rec_gate_x_w': nrm((N_REC_LAYERS, 2, RNN_BLOCKS, RNN_BW, RNN_BW), RNN_BW ** -0.5),
        'rec_gate_x_b': nrm((N_REC_LAYERS, 2, D_RNN), 0.02),
        'rec_lambda': jnp.log(u) - jnp.log1p(-u),
        'rec_w_out': nrm((N_REC_LAYERS, D_RNN, D), beta * D_RNN ** -0.5),
        'att_w_qkv': nrm((N_ATT_LAYERS, D, (N_HEADS + 2 * N_KV_HEADS) * HEAD_DIM), D ** -0.5),
        'att_sink': nrm((N_ATT_LAYERS, N_HEADS), 0.5),
        'att_w_o': nrm((N_ATT_LAYERS, N_HEADS * HEAD_DIM, D), beta * (N_HEADS * HEAD_DIM) ** -0.5),
    }


def reference(x, c, ctx, c_ctx, mod_w, mod_b, ln_mix_g, ln_mix_b, ln_ffn_g, ln_ffn_b,
              ffn_w_gate, ffn_w_up, ffn_w_down, rec_w_in, rec_conv_w, rec_conv_b,
              rec_gate_a_w, rec_gate_a_b, rec_gate_x_w, rec_gate_x_b, rec_lambda, rec_w_out,
              att_w_qkv, att_sink, att_w_o):
    S = x.shape[1]
    cos, sin = axial_rope_tables(S)
    alpha = (2.0 * DEPTH) ** 0.25
    hx, hc = x, ctx
    for i in range(DEPTH):
        last = i == DEPTH - 1
        j = i // N_MIXERS
        mod_x = jax.nn.silu(c) @ mod_w[i] + mod_b[i]
        mod_c = jax.nn.silu(c_ctx) @ mod_w[i] + mod_b[i]
        sh1x, sc1x, g1x, sh2x, sc2x, g2x = jnp.split(mod_x[:, None, :], 6, axis=-1)
        sh1c, sc1c, g1c, sh2c, sc2c, g2c = jnp.split(mod_c, 6)
        ux = modulate(hx, sh1x, sc1x)
        uc = modulate(hc, sh1c, sc1c)
        if i % N_MIXERS == 0:
            oc, ox = recurrent_mixer(uc, ux, rec_w_in[j], rec_conv_w[j], rec_conv_b[j],
                                     rec_gate_a_w[j], rec_gate_a_b[j], rec_gate_x_w[j], rec_gate_x_b[j],
                                     rec_lambda[j], rec_w_out[j], not last)
        else:
            oc, ox = attention_mixer(uc, ux, att_w_qkv[j], att_sink[j], att_w_o[j], cos, sin, not last)
        hx = layer_norm(alpha * hx + g1x * ox, ln_mix_g[i], ln_mix_b[i])
        hx = layer_norm(alpha * hx + g2x * swiglu(modulate(hx, sh2x, sc2x), ffn_w_gate[i], ffn_w_up[i], ffn_w_down[i]),
                        ln_ffn_g[i], ln_ffn_b[i])
        if not last:
            hc = layer_norm(alpha * hc + g1c * oc, ln_mix_g[i], ln_mix_b[i])
            hc = layer_norm(alpha * hc + g2c * swiglu(modulate(hc, sh2c, sc2c), ffn_w_gate[i], ffn_w_up[i], ffn_w_down[i]),
                            ln_ffn_g[i], ln_ffn_b[i])
    return hx
```

```cpp
#include <hip/hip_runtime.h>
#include <cstdint>
#include <cstdio>

#define LAS __attribute__((address_space(3)))
#define GAS __attribute__((address_space(1)))
typedef unsigned short bf16_t;
typedef short bf16x8 __attribute__((ext_vector_type(8)));
typedef short bf16x4 __attribute__((ext_vector_type(4)));
typedef float f32x4 __attribute__((ext_vector_type(4)));
typedef float f32x2 __attribute__((ext_vector_type(2)));
typedef float f32x16 __attribute__((ext_vector_type(16)));
typedef unsigned u32x4 __attribute__((ext_vector_type(4)));
typedef unsigned u32x2 __attribute__((ext_vector_type(2)));

constexpr int D = 2048, SEQ = 4096, CTXL = 256, NBATCH = 4, ML = NBATCH * SEQ, MC = NBATCH * CTXL, MT = ML + MC;
constexpr int DR = 2816, FF = 5632, NQK = 2560, NVV = 512, NQKV = 3072, MODN = 6 * D, DEPTH = 4, BW = 176, ZP = 3072, NWAVES = 8;
constexpr float ALPHA = 1.6817928305074292f, LN_EPS = 1e-5f, LOG2E = 1.4426950408889634f;
constexpr float QSCALE = 0.08838834764831845f * 1.4426950408889634f;

constexpr size_t MiB = 1u << 20;
constexpr size_t WS_CTL = 0, CTL_ZERO_BYTES = 1 * MiB;
constexpr size_t WS_MODV = 1 * MiB, WS_ROPE = 2 * MiB;
constexpr size_t WS_WGU = 4 * MiB;
constexpr size_t WS_WD = WS_WGU + 4 * (size_t)(2 * FF) * D * 2;
constexpr size_t WS_WIN = WS_WD + 4 * (size_t)D * FF * 2;
constexpr size_t WS_WOUT = WS_WIN + 2 * (size_t)FF * D * 2;
constexpr size_t WS_WQKV = WS_WOUT + 2 * (size_t)D * DR * 2;
constexpr size_t WS_WO = WS_WQKV + 2 * (size_t)NQKV * D * 2;
constexpr size_t WS_HA = WS_WO + 2 * (size_t)D * D * 2;
constexpr size_t WS_U = WS_HA + (size_t)MT * D * 4;
constexpr size_t WS_BIG = WS_U + (size_t)MT * D * 2;
constexpr size_t WS_Z = WS_BIG + (size_t)MT * FF * 2;
constexpr size_t WS_V = WS_Z + (size_t)MT * ZP * 2;
constexpr size_t WS_HF = WS_V + (size_t)MT * DR * 2;
constexpr size_t WS_END = WS_HF + (size_t)MT * DR * 4;
namespace pg8 {
#define PG8_LAS __attribute__((address_space(3)))
typedef unsigned short bf16_t;
typedef short bf16x8 __attribute__((ext_vector_type(8)));
typedef float f32x4 __attribute__((ext_vector_type(4)));
typedef unsigned u32x4 __attribute__((ext_vector_type(4)));
constexpr int BM = 256, BK = 64, HALF = 128, HTB = HALF * BK * 2  , STAGE_BYTES = 8 * HTB, NXCD = 8, WGM = 8;

__host__ __device__ __forceinline__ int lds_byte(int r, int c) { const int st = (r >> 4) * 2 + (c >> 5), rr = r & 15, cc = c & 31, ob = rr * 64 + cc * 2; return st * 1024 + (ob ^ (((ob >> 9) & 1) << 5)); }
__host__ __device__ __forceinline__ void stage_rc(int b, int& R, int& C) { const int st = b / 1024, sb = b % 1024, swz = sb ^ (((sb >> 9) & 1) << 5); R = (st >> 1) * 16 + swz / 64; C = (st & 1) * 32 + (swz % 64) / 2; }
__host__ __device__ __forceinline__ int perm32(int rho) { const int n = rho >> 4, i = rho & 15; return 8 * (i >> 2) + 4 * n + (i & 3); }

struct Unit { int pm, pn; };
struct Gemm { const bf16_t* A; const bf16_t* Bt; int M, N, K; };

struct StaticOrder {
    int nM, nN, nwg, G, c;
    __host__ __device__ void init(int M, int N, int G_, int c_) { nM = M / BM; nN = N / BM; nwg = nM * nN; G = G_; c = c_; }
    __host__ __device__ bool next(int i, Unit& u) const {
        const long L = (long)i * G + c; if (L >= nwg) return false;
        int wgid = (int)L; { const int q = nwg / NXCD, r = nwg % NXCD, xcd = wgid % NXCD, off = wgid / NXCD; wgid = (xcd < r ? xcd * (q + 1) : r * (q + 1) + (xcd - r) * q) + off; }
        const int nig = WGM * nN, gid = wgid / nig, fm = gid * WGM, gsz = (nM - fm) < WGM ? (nM - fm) : WGM;
        u.pm = fm + ((wgid % nig) % gsz); u.pn = (wgid % nig) / gsz; return true;
    }
    __device__ __forceinline__ void a_ready(const Unit&) const {}
    __device__ __forceinline__ void done(const Unit&) const {}
};

__device__ __forceinline__ unsigned cvt_pk_bf16(float lo, float hi) { unsigned r; asm volatile("v_cvt_pk_bf16_f32 %0, %1, %2" : "=v"(r) : "v"(lo), "v"(hi)); return r; }
__device__ __forceinline__ float sigmoid_fast(float x) { return __builtin_amdgcn_rcpf(1.0f + __builtin_amdgcn_exp2f(-1.4426950408889634f * x)); }
__device__ __forceinline__ float gelu_tanh_fast(float x) { const float y = x * (1.5957691216057308f + 0.07135481627159498f * x * x); return x * sigmoid_fast(y); }
__device__ __forceinline__ u32x4 pack8(const f32x4 a, const f32x4 b) { u32x4 w; w.x = cvt_pk_bf16(a[0], a[1]); w.y = cvt_pk_bf16(a[2], a[3]); w.z = cvt_pk_bf16(b[0], b[1]); w.w = cvt_pk_bf16(b[2], b[3]); return w; }

struct EpiBf16 {
    static constexpr bool PERM = true, AFTER_DRAIN = false;
    bf16_t* O; int ldc; int gelu_tiles;
    __device__ __forceinline__ void operator()(const f32x4 (&acc)[2][2][4][2], const Unit& u, int wr, int wc, int fr, int fq) const {
        const int row0 = u.pm * BM + wr * 64 + fr, col0 = u.pn * BM + wc * 32 + 8 * fq; const bool act = u.pn < gelu_tiles;
#pragma unroll
        for (int ai = 0; ai < 2; ++ai)
#pragma unroll
            for (int m = 0; m < 4; ++m) { bf16_t* rowp = O + (size_t)(row0 + ai * HALF + m * 16) * ldc + col0;
#pragma unroll
                for (int bj = 0; bj < 2; ++bj) { f32x4 v0 = acc[ai][bj][m][0], v1 = acc[ai][bj][m][1];
                    if (act) {
#pragma unroll
                        for (int e = 0; e < 4; ++e) { v0[e] = gelu_tanh_fast(v0[e]); v1[e] = gelu_tanh_fast(v1[e]); } }
                    *(u32x4*)(rowp + bj * HALF) = pack8(v0, v1); } }
    }
};
struct EpiGU {
    static constexpr bool PERM = true, AFTER_DRAIN = false;
    bf16_t* O; int ldc;
    __device__ __forceinline__ void operator()(const f32x4 (&acc)[2][2][4][2], const Unit& u, int wr, int wc, int fr, int fq) const {
        const int row0 = u.pm * BM + wr * 64 + fr, col0 = u.pn * HALF + wc * 32 + 8 * fq;
#pragma unroll
        for (int ai = 0; ai < 2; ++ai)
#pragma unroll
            for (int m = 0; m < 4; ++m) { f32x4 o0, o1;
#pragma unroll
                for (int e = 0; e < 4; ++e) { const float g0 = acc[ai][0][m][0][e], g1 = acc[ai][0][m][1][e];
                    o0[e] = g0 * sigmoid_fast(g0) * acc[ai][1][m][0][e]; o1[e] = g1 * sigmoid_fast(g1) * acc[ai][1][m][1][e]; }
                *(u32x4*)(O + (size_t)(row0 + ai * HALF + m * 16) * ldc + col0) = pack8(o0, o1); }
    }
};
struct EpiRes {
    static constexpr bool PERM = false, AFTER_DRAIN = false;
    float* HA; int ldc; const float* gate;
    int gate_ld;
    __device__ __forceinline__ void operator()(const f32x4 (&acc)[2][2][4][2], const Unit& u, int wr, int wc, int fr, int fq) const {
        const int r = u.pm < 64 ? (u.pm >> 4) : 4; const int col0 = u.pn * BM + wc * 32 + 4 * fq; const float* g = gate + (size_t)r * gate_ld + col0;
        f32x4 gv[2][2];
#pragma unroll
        for (int bj = 0; bj < 2; ++bj)
#pragma unroll
            for (int n = 0; n < 2; ++n) gv[bj][n] = *(const f32x4*)(g + bj * HALF + n * 16);
#pragma unroll
        for (int ai = 0; ai < 2; ++ai)
#pragma unroll
            for (int m = 0; m < 4; ++m) { float* p = HA + (size_t)(u.pm * BM + ai * HALF + wr * 64 + m * 16 + fr) * ldc + col0; f32x4 hv[2][2];
#pragma unroll
                for (int bj = 0; bj < 2; ++bj)
#pragma unroll
                    for (int n = 0; n < 2; ++n) hv[bj][n] = *(const f32x4*)(p + bj * HALF + n * 16);
#pragma unroll
                for (int bj = 0; bj < 2; ++bj)
#pragma unroll
                    for (int n = 0; n < 2; ++n) *(f32x4*)(p + bj * HALF + n * 16) = hv[bj][n] + gv[bj][n] * acc[ai][bj][m][n];
                if (m & 1) asm volatile("" ::: "memory"); }
    }
};
struct EpiQK {
    static constexpr bool PERM = true, AFTER_DRAIN = false;
    bf16_t* O; const f32x2* tab;
    __device__ __forceinline__ void operator()(const f32x4 (&acc)[2][2][4][2], const Unit& u, int wr, int wc, int fr, int fq) const {
        const int row0 = u.pm * BM + wr * 64 + fr; const bool latent = u.pm < 64; const float qs = u.pn < 8 ? 0.12751743082459868f : 1.0f;
        const int colA = u.pn * BM + (wc >> 1) * HALF + 32 * (wc & 1) + 8 * fq;
#pragma unroll
        for (int ai = 0; ai < 2; ++ai)
#pragma unroll
            for (int m = 0; m < 4; ++m) { const int row = row0 + ai * HALF + m * 16; const int t = row & 4095; const int pos = (wc & 1) ? (t & 63) : (t >> 6);
                const f32x4* tp = (const f32x4*)(tab + pos * 32 + 8 * fq); f32x4 o1[2], o2[2];
#pragma unroll
                for (int n = 0; n < 2; ++n) { f32x4 cs0 = (f32x4){1.f, 0.f, 1.f, 0.f}, cs1 = cs0;
                    if (latent) { cs0 = tp[2 * n]; cs1 = tp[2 * n + 1]; }
                    const f32x4 t1 = acc[ai][0][m][n], t2 = acc[ai][1][m][n];
                    o1[n][0] = (t1[0] * cs0[0] - t2[0] * cs0[1]) * qs; o2[n][0] = (t2[0] * cs0[0] + t1[0] * cs0[1]) * qs;
                    o1[n][1] = (t1[1] * cs0[2] - t2[1] * cs0[3]) * qs; o2[n][1] = (t2[1] * cs0[2] + t1[1] * cs0[3]) * qs;
                    o1[n][2] = (t1[2] * cs1[0] - t2[2] * cs1[1]) * qs; o2[n][2] = (t2[2] * cs1[0] + t1[2] * cs1[1]) * qs;
                    o1[n][3] = (t1[3] * cs1[2] - t2[3] * cs1[3]) * qs; o2[n][3] = (t2[3] * cs1[2] + t1[3] * cs1[3]) * qs; }
                bf16_t* rowp = O + (size_t)row * NQK + colA;
                *(u32x4*)(rowp) = pack8(o1[0], o1[1]); *(u32x4*)(rowp + 64) = pack8(o2[0], o2[1]); }
    }
};

template <class Epi, class Sched, bool ALIGN_EPI = false, bool SP2 = false>
__device__ __forceinline__ void gemm_phase(PG8_LAS unsigned char* lds, const Gemm g, const Sched& S, const Epi& E) {
    int tid_ = threadIdx.x; asm volatile("" : "+v"(tid_));
    const int tid = tid_, wid = __builtin_amdgcn_readfirstlane(tid >> 6), lane = tid & 63, wr = wid >> 2, wc = wid & 3, fr = lane & 15, fq = lane >> 4;
    const int K = g.K, nt = K / BK;
    unsigned voffA[2], voffB[2];
#pragma unroll
    for (int i = 0; i < 2; ++i) { int R, C; stage_rc(tid * 16 + i * 8192, R, C); const int Rb = Epi::PERM ? ((R & ~31) + perm32(R & 31)) : R;
        voffA[i] = (unsigned)(R * K + C) * 2u; voffB[i] = (unsigned)(Rb * K + C) * 2u; }
    const size_t kstep = (size_t)(BK * 2);
    const size_t hstep = (size_t)HALF * K * 2;
    const size_t tstep = 2 * hstep;
    const unsigned ldsw = (unsigned)wid * 1024u;
    const int aoff = lds_byte(wr * 64 + fr, fq * 8), boff = lds_byte(wc * 32 + fr, fq * 8);
#define PG8_SA(b, h) (((b) * 2 + (h)) * HTB)
#define PG8_SB(b, h) ((4 + (b) * 2 + (h)) * HTB)
#define PG8_STAGE(bufoff, gbase, voff) do { _Pragma("unroll") for (int _i = 0; _i < 2; ++_i) \
        __builtin_amdgcn_global_load_lds((const unsigned*)((const char*)(gbase) + (voff)[_i]), (PG8_LAS unsigned*)(lds + (bufoff) + ldsw + _i * 8192), 16, 0, 0); } while (0)
#define PG8_LDA(dst, b, h) do { _Pragma("unroll") for (int m = 0; m < 4; ++m) _Pragma("unroll") for (int k = 0; k < 2; ++k) dst[m][k] = *(const PG8_LAS bf16x8*)(lds + PG8_SA(b, h) + aoff + m * 2048 + k * 1024); } while (0)
#define PG8_LDB(dst, b, h) do { _Pragma("unroll") for (int n = 0; n < 2; ++n) _Pragma("unroll") for (int k = 0; k < 2; ++k) dst[n][k] = *(const PG8_LAS bf16x8*)(lds + PG8_SB(b, h) + boff + n * 2048 + k * 1024); } while (0)
#define PG8_MMA(ai, bj, At, Bt) do { __builtin_amdgcn_s_setprio(1); _Pragma("unroll") for (int m = 0; m < 4; ++m) _Pragma("unroll") for (int n = 0; n < 2; ++n) _Pragma("unroll") for (int k = 0; k < 2; ++k) \
        acc[ai][bj][m][n] = __builtin_amdgcn_mfma_f32_16x16x32_bf16(Bt[n][k], At[m][k], acc[ai][bj][m][n], 0, 0, 0); __builtin_amdgcn_s_setprio(0); } while (0)
#define PG8_WAIT_V(n) asm volatile("s_waitcnt vmcnt(" #n ")" ::: "memory")
#define PG8_WAIT_L(n) asm volatile("s_waitcnt lgkmcnt(" #n ")" ::: "memory")
#define PG8_BAR __builtin_amdgcn_s_barrier()
#define PG8_SCHED __builtin_amdgcn_sched_barrier(0)
    Unit cur, nxt; int ui = 0;
    if (!S.next(0, cur)) return;
    f32x4 acc[2][2][4][2];
#pragma unroll
    for (int a = 0; a < 2; ++a)
#pragma unroll
        for (int b = 0; b < 2; ++b)
#pragma unroll
            for (int m = 0; m < 4; ++m)
#pragma unroll
                for (int n = 0; n < 2; ++n) acc[a][b][m][n] = (f32x4){0.f, 0.f, 0.f, 0.f};
    bf16x8 At[4][2], B0[2][2], B1[2][2];
    const char* cA = (const char*)g.A + (size_t)cur.pm * tstep; const char* cB = (const char*)g.Bt + (size_t)cur.pn * tstep;
    S.a_ready(cur);
    if constexpr (SP2) {
        PG8_STAGE(PG8_SB(0, 0), cB, voffB); PG8_STAGE(PG8_SB(0, 1), cB + hstep, voffB); PG8_STAGE(PG8_SA(0, 0), cA, voffA); PG8_STAGE(PG8_SA(0, 1), cA + hstep, voffA);
        if (wr == 1) PG8_BAR;
        PG8_WAIT_V(2); PG8_BAR;
        PG8_STAGE(PG8_SB(1, 0), cB + kstep, voffB); PG8_STAGE(PG8_SA(1, 0), cA + kstep, voffA); PG8_STAGE(PG8_SB(1, 1), cB + hstep + kstep, voffB);
        PG8_WAIT_V(6); PG8_BAR;
    } else {
        PG8_STAGE(PG8_SB(0, 0), cB, voffB); PG8_STAGE(PG8_SA(0, 0), cA, voffA); PG8_STAGE(PG8_SB(0, 1), cB + hstep, voffB); PG8_STAGE(PG8_SA(0, 1), cA + hstep, voffA);
        if (wr == 1) PG8_BAR;
        PG8_WAIT_V(4); PG8_BAR;
        PG8_STAGE(PG8_SB(1, 0), cB + kstep, voffB); PG8_STAGE(PG8_SA(1, 0), cA + kstep, voffA); PG8_STAGE(PG8_SB(1, 1), cB + hstep + kstep, voffB);
        PG8_WAIT_V(6); PG8_BAR;
    }
    for (;;) {
        const bool has_next = S.next(ui + 1, nxt);
        const char* nA = has_next ? (const char*)g.A + (size_t)nxt.pm * tstep : cA; const char* nB = has_next ? (const char*)g.Bt + (size_t)nxt.pn * tstep : cB;
        for (int t = 0; t < nt; t += 2) {
            const bool last = (t == nt - 2);
            const char* a1 = cA + (size_t)(t + 1) * kstep;
            const char* a2 = last ? nA : cA + (size_t)(t + 2) * kstep; const char* b2 = last ? nB : cB + (size_t)(t + 2) * kstep;
            const char* a3 = a2 + kstep; const char* b3 = b2 + kstep;
            if (last && has_next) S.a_ready(nxt);
            if constexpr (SP2) {
            PG8_LDB(B0, 0, 0); PG8_LDB(B1, 0, 1); PG8_SCHED; PG8_LDA(At, 0, 0); PG8_STAGE(PG8_SA(1, 1), a1 + hstep, voffA);
            PG8_WAIT_V(8); PG8_WAIT_L(0); PG8_BAR; PG8_MMA(0, 0, At, B0); PG8_MMA(0, 1, At, B1); PG8_BAR; PG8_SCHED;
            PG8_LDA(At, 0, 1); PG8_STAGE(PG8_SB(0, 0), b2, voffB); PG8_STAGE(PG8_SB(0, 1), b2 + hstep, voffB); PG8_STAGE(PG8_SA(0, 0), a2, voffA);
            PG8_WAIT_V(8); PG8_WAIT_L(0); PG8_BAR; PG8_MMA(1, 0, At, B0); PG8_MMA(1, 1, At, B1); PG8_BAR; PG8_SCHED;
            PG8_LDB(B0, 1, 0); PG8_LDB(B1, 1, 1); PG8_SCHED; PG8_LDA(At, 1, 0); PG8_STAGE(PG8_SA(0, 1), a2 + hstep, voffA);
            PG8_WAIT_V(8); PG8_WAIT_L(0); PG8_BAR; PG8_MMA(0, 0, At, B0); PG8_MMA(0, 1, At, B1); PG8_BAR; PG8_SCHED;
            PG8_LDA(At, 1, 1); PG8_STAGE(PG8_SB(1, 0), b3, voffB); PG8_STAGE(PG8_SB(1, 1), b3 + hstep, voffB); PG8_STAGE(PG8_SA(1, 0), a3, voffA);
            PG8_WAIT_V(8); PG8_WAIT_L(0); PG8_BAR; PG8_MMA(1, 0, At, B0); PG8_MMA(1, 1, At, B1); PG8_BAR; PG8_SCHED;
            } else {
            PG8_LDB(B0, 0, 0); PG8_SCHED; PG8_LDA(At, 0, 0); PG8_STAGE(PG8_SA(1, 1), a1 + hstep, voffA);
            PG8_WAIT_L(8); PG8_BAR; PG8_WAIT_L(0); PG8_MMA(0, 0, At, B0); PG8_BAR; PG8_SCHED;
            PG8_LDB(B1, 0, 1); PG8_STAGE(PG8_SB(0, 0), b2, voffB);
            PG8_BAR; PG8_WAIT_L(0); PG8_MMA(0, 1, At, B1); PG8_BAR;
            PG8_LDA(At, 0, 1); PG8_STAGE(PG8_SA(0, 0), a2, voffA);
            PG8_BAR; PG8_WAIT_L(0); PG8_MMA(1, 0, At, B0); PG8_BAR; PG8_SCHED;
            PG8_STAGE(PG8_SB(0, 1), b2 + hstep, voffB);
            PG8_WAIT_V(6); PG8_BAR; PG8_MMA(1, 1, At, B1); PG8_BAR;
            PG8_LDB(B0, 1, 0); PG8_SCHED; PG8_LDA(At, 1, 0); PG8_STAGE(PG8_SA(0, 1), a2 + hstep, voffA);
            PG8_WAIT_L(8); PG8_BAR; PG8_WAIT_L(0); PG8_MMA(0, 0, At, B0); PG8_BAR; PG8_SCHED;
            PG8_LDB(B1, 1, 1); PG8_STAGE(PG8_SB(1, 0), b3, voffB);
            PG8_BAR; PG8_WAIT_L(0); PG8_MMA(0, 1, At, B1); PG8_BAR;
            PG8_LDA(At, 1, 1); PG8_STAGE(PG8_SA(1, 0), a3, voffA);
            PG8_BAR; PG8_WAIT_L(0); PG8_MMA(1, 0, At, B0); PG8_BAR; PG8_SCHED;
            PG8_STAGE(PG8_SB(1, 1), b3 + hstep, voffB);
            PG8_WAIT_V(6); PG8_BAR; PG8_MMA(1, 1, At, B1); PG8_BAR;
            }
        }
        if constexpr (ALIGN_EPI) { if (wr == 0) PG8_BAR; }
        if constexpr (!Epi::AFTER_DRAIN) { E(acc, cur, wr, wc, fr, fq); S.done(cur); }
        if (!has_next) break;
#pragma unroll
        for (int a = 0; a < 2; ++a)
#pragma unroll
            for (int b = 0; b < 2; ++b)
#pragma unroll
                for (int m = 0; m < 4; ++m)
#pragma unroll
                    for (int n = 0; n < 2; ++n) acc[a][b][m][n] = (f32x4){0.f, 0.f, 0.f, 0.f};
        cur = nxt; cA = nA; cB = nB; ++ui;
        if constexpr (ALIGN_EPI) { if (wr == 1) PG8_BAR; }
    }
    PG8_WAIT_V(0);
    if constexpr (!ALIGN_EPI) { if (wr == 0) PG8_BAR; }
    PG8_BAR;
    if constexpr (Epi::AFTER_DRAIN) { E.fused(acc, cur, wr, wc, fr, fq, lds, wid, lane); S.done(cur); }
#undef PG8_SA
#undef PG8_SB
#undef PG8_STAGE
#undef PG8_LDA
#undef PG8_LDB
#undef PG8_MMA
#undef PG8_WAIT_V
#undef PG8_WAIT_L
#undef PG8_BAR
#undef PG8_SCHED
}
}

#ifndef PG8_SP2
#define PG8_SP2 true
#endif
#ifndef PG8_ALIGN
#define PG8_ALIGN true
#endif
constexpr int RING_OFF = 0, RING_BYTES = 131072;
constexpr int LDSCTL_OFF = RING_BYTES, MISC_OFF = LDSCTL_OFF + 320;
constexpr int LDS_BYTES = 147456;

typedef GAS unsigned gu32;
#define RLX_AGENT __ATOMIC_RELAXED, __HIP_MEMORY_SCOPE_AGENT
#define LDS_WAIT() asm volatile("s_waitcnt lgkmcnt(0)" ::: "memory")
#define VM_WAIT() asm volatile("s_waitcnt vmcnt(0)" ::: "memory")
constexpr int CW_BAR = 4096;
#define XB_TMO      128
#define XB_XCNT(j)  (256  + 64 * (j))
#define XB_XSUB(j)  (1280 + 64 * (j))
#define XB_XGEN(j)  (2304 + 64 * (j))
#define XB_TOP      3328
#define XB_TOPGEN   3392
#define XCD_BAR_WORDS 3456
#define XB_SPIN_CAP (1u << 18)

__device__ __forceinline__ unsigned xb_ld(unsigned* p)              { return __hip_atomic_load(p, __ATOMIC_RELAXED, __HIP_MEMORY_SCOPE_AGENT); }
__device__ __forceinline__ unsigned xb_add(unsigned* p, unsigned v) { return __hip_atomic_fetch_add(p, v, __ATOMIC_RELAXED, __HIP_MEMORY_SCOPE_AGENT); }
__device__ __forceinline__ unsigned xb_xcc_id() { return (unsigned)__builtin_amdgcn_s_getreg((3 << 11) | 20) & 0xFu; }
#define XB_SPIN(cond, bar) do { unsigned _sp = 0; while (cond) { __builtin_amdgcn_s_sleep(1); \
    if ((++_sp & 255u) == 0u) { if (xb_ld(&(bar)[XB_TMO])) break; if (_sp > XB_SPIN_CAP) { atomicAdd(&(bar)[XB_TMO], 1u); break; } } } } while (0)

struct XcdBarrier {
    unsigned* bar; unsigned x;
    volatile LAS unsigned* st;
};

__device__ __forceinline__ XcdBarrier xcd_barrier_post(unsigned* bar, volatile LAS unsigned* st) {
    XcdBarrier b; b.bar = bar; b.x = xb_xcc_id(); b.st = st;
    if (threadIdx.x == 0) (void)xb_add(&bar[XB_XCNT(b.x)], 1u);
    return b;
}
__device__ __forceinline__ void xcd_barrier_complete(unsigned* bar, unsigned x, unsigned& nloc, unsigned& nx) {
    const unsigned G = gridDim.x * gridDim.y * gridDim.z;
    unsigned sum, cnt, mine, sp = 0u;
    for (;;) {
        sum = 0u; cnt = 0u; mine = 0u;
#pragma unroll
        for (unsigned j = 0; j < 16; ++j) { const unsigned c = xb_ld(&bar[XB_XCNT(j)]); sum += c; cnt += (c > 0u) ? 1u : 0u; mine = (j == x) ? c : mine; }
        if (sum == G) break;
        __builtin_amdgcn_s_sleep(1);
        if ((++sp & 255u) == 0u) { if (xb_ld(&bar[XB_TMO])) break; if (sp > XB_SPIN_CAP) { atomicAdd(&bar[XB_TMO], 1u); break; } }
    }
    nloc = mine > 0u ? mine : 1u; nx = cnt > 0u ? cnt : 1u;
}

__device__ __forceinline__ void xcd_barrier(const XcdBarrier& b) {
    asm volatile("s_waitcnt vmcnt(0)" ::: "memory");
    __syncthreads();
    if (threadIdx.x == 0) {
        unsigned* bar = b.bar;
        __builtin_amdgcn_s_waitcnt(0);
        unsigned nloc = b.st[0], nx = b.st[1];
        if (nloc == 0u) { xcd_barrier_complete(bar, b.x, nloc, nx); b.st[0] = nloc; b.st[1] = nx; }
        const unsigned old = xb_add(&bar[XB_XSUB(b.x)], 1u);
        const unsigned gen = old / nloc;
        if (old + 1u == (gen + 1u) * nloc) {
            __builtin_amdgcn_fence(__ATOMIC_RELEASE, "agent");
            asm volatile("s_waitcnt vmcnt(0)" ::: "memory");
            const unsigned og = xb_add(&bar[XB_TOP], 1u);
            const unsigned tg = og / nx;
            if (og + 1u == (tg + 1u) * nx) xb_add(&bar[XB_TOPGEN], 1u);
            else XB_SPIN(xb_ld(&bar[XB_TOPGEN]) == tg, bar);
            __builtin_amdgcn_fence(__ATOMIC_ACQUIRE, "agent");
            xb_add(&bar[XB_XGEN(b.x)], 1u);
            asm volatile("s_waitcnt vmcnt(0)" ::: "memory");
        } else {
            XB_SPIN(xb_ld(&bar[XB_XGEN(b.x)]) == gen, bar);
            __builtin_amdgcn_fence(__ATOMIC_ACQUIRE, "agent");
            asm volatile("s_waitcnt vmcnt(0)" ::: "memory");
        }
    }
    __syncthreads();
}

typedef __attribute__((address_space(4))) const unsigned long long* kargp_t;
struct Frame {
    LAS unsigned char* lds;
    int tid, lane, wave, G, gw, ngw;
    unsigned char* ws;
    kargp_t kp; int cu;
};
__device__ __forceinline__ kargp_t kargs() {
    const unsigned long long v = (unsigned long long)__builtin_amdgcn_kernarg_segment_ptr(); unsigned lo = (unsigned)v, hi = (unsigned)(v >> 32);
    asm volatile("" : "+s"(lo), "+s"(hi)); return (kargp_t)(((unsigned long long)hi << 32) | lo);
}
__device__ __forceinline__ void relaunder(Frame& F) {
    int t = threadIdx.x; asm volatile("" : "+v"(t));
    int bx = __builtin_amdgcn_readfirstlane((int)blockIdx.x); asm volatile("" : "+s"(bx));
    F.kp = kargs(); F.ws = (unsigned char*)(GAS unsigned char*)F.kp[26]; F.cu = bx;
    F.tid = t; F.lane = t & 63; F.wave = __builtin_amdgcn_readfirstlane(t >> 6); F.gw = bx * NWAVES + F.wave;
}
__device__ __forceinline__ float wave_sum(float v) {
#pragma unroll
    for (int o = 1; o < 64; o <<= 1) v += __shfl_xor(v, o);
    return v;
}
__device__ __forceinline__ float bf2f(unsigned short x) { return __uint_as_float((unsigned)x << 16); }
__device__ __forceinline__ float bflo(unsigned x) { return __uint_as_float(x << 16); }
__device__ __forceinline__ float bfhi(unsigned x) { return __uint_as_float(x & 0xffff0000u); }
using pg8::cvt_pk_bf16;
using pg8::sigmoid_fast;

enum { I_X = 0, I_C, I_CTX, I_CCTX, I_MODW, I_MODB, I_LNMG, I_LNMB, I_LNFG, I_LNFB, I_WG, I_WU, I_WDN, I_WIN, I_CONVW, I_CONVB, I_GAW, I_GAB, I_GXW, I_GXB, I_LAM, I_WOUT, I_WQKV, I_SINK, I_WO };

__device__ __forceinline__ void p0_transpose_item(const float* W, int K, int N, bf16_t* WT, int k0, int n0, int drow0, LAS float* scr, int lane) {
#pragma unroll 8
    for (int i = 0; i < 32; ++i) { const int kk = 2 * i + (lane >> 5); scr[kk * 33 + (lane & 31)] = W[(size_t)(k0 + kk) * N + n0 + (lane & 31)]; }
    LDS_WAIT(); asm volatile("" ::: "memory");
    const int c = lane & 7;
#pragma unroll
    for (int j = 0; j < 4; ++j) { const int n = (lane >> 3) + 8 * j; const LAS float* s = scr + (8 * c) * 33 + n;
        u32x4 o; o.x = cvt_pk_bf16(s[0 * 33], s[1 * 33]); o.y = cvt_pk_bf16(s[2 * 33], s[3 * 33]); o.z = cvt_pk_bf16(s[4 * 33], s[5 * 33]); o.w = cvt_pk_bf16(s[6 * 33], s[7 * 33]);
        *(GAS u32x4*)(WT + (size_t)(drow0 + n) * K + k0 + 8 * c) = o; }
    LDS_WAIT(); asm volatile("" ::: "memory");
}
__device__ __forceinline__ float silu_acc(float x) { return x / (1.f + expf(-x)); }

__device__ __forceinline__ void phase_p0a(Frame& F) {
    relaunder(F);
    const int bx = F.cu;
    if (bx < DEPTH * (MODN / 256)) {
        const int L = bx / (MODN / 256), nb = bx % (MODN / 256);
        LAS float* sl = (LAS float*)(F.lds);
        LAS float* red = (LAS float*)(F.lds + 5 * D * 4);
        const float* c = ((const float*)(GAS const float*)F.kp[I_C]); const float* cc = ((const float*)(GAS const float*)F.kp[I_CCTX]);
        for (int i = F.tid; i < 5 * D; i += NWAVES * 64) { const int r = i / D, k = i % D; sl[i] = silu_acc(r < 4 ? c[r * D + k] : cc[k]); }
        __syncthreads();
        const float* W = ((const float*)(GAS const float*)F.kp[I_MODW]) + ((size_t)L * D + F.wave * 256) * MODN + nb * 256 + F.lane * 4;
        f32x4 a0 = {0.f, 0.f, 0.f, 0.f}, a1 = a0, a2 = a0, a3 = a0, a4 = a0;
        const LAS float* s0 = sl + F.wave * 256;
#pragma unroll 8
        for (int k = 0; k < 256; ++k) { const f32x4 w = *(const f32x4*)(W + (size_t)k * MODN);
            a0 += w * s0[k]; a1 += w * s0[D + k]; a2 += w * s0[2 * D + k]; a3 += w * s0[3 * D + k]; a4 += w * s0[4 * D + k]; }
        LAS f32x4* rw = (LAS f32x4*)(red + F.wave * 5 * 256) + F.lane;
        rw[0] = a0; rw[64] = a1; rw[128] = a2; rw[192] = a3; rw[256] = a4;
        __syncthreads();
        float* modv = (float*)(F.ws + WS_MODV);
        for (int o = F.tid; o < 5 * 256; o += NWAVES * 64) { const int r = o >> 8, n = o & 255; float s = 0.f;
#pragma unroll
            for (int w = 0; w < 8; ++w) s += red[w * 5 * 256 + r * 256 + n];
            modv[((size_t)L * 5 + r) * MODN + nb * 256 + n] = s + ((const float*)(GAS const float*)F.kp[I_MODB])[(size_t)L * MODN + nb * 256 + n]; }
        __syncthreads();
    } else if (bx == 255) {
        f32x2* tab = (f32x2*)(F.ws + WS_ROPE);
        for (int i = F.tid; i < 64 * 32; i += NWAVES * 64) { const int pos = i >> 5, f = i & 31; const float inv = powf(10000.f, -(float)(2 * f) / 64.f); const float ang = (float)pos * inv;
            tab[i] = (f32x2){cosf(ang), sinf(ang)}; }
    }
    LAS float* scr = (LAS float*)(F.lds + F.wave * 8448);
    constexpr int IT_FFN = (D / 64) * (FF / 32);
    constexpr int IT_WIN = IT_FFN, IT_WOUT = (DR / 64) * (D / 32);
    constexpr int IT_QKV = (D / 64) * (NQKV / 32), IT_WO = (D / 64) * (D / 32);
    constexpr int N_FFN = DEPTH * 3 * IT_FFN, N_REC = 2 * (IT_WIN + IT_WOUT), N_ATT = 2 * (IT_QKV + IT_WO), NITEMS = N_FFN + N_REC + N_ATT;
    for (int it = F.gw; it < NITEMS; it += F.ngw) {
        int r = it;
        if (r < N_FFN) {
            const int L = r / (3 * IT_FFN), w = (r / IT_FFN) % 3, q = r % IT_FFN;
            if (w < 2) {
                const int nblk = FF / 32, kb = q / nblk, nb = q % nblk, n0 = nb * 32;
                p0_transpose_item(((const float*)(GAS const float*)F.kp[w == 0 ? I_WG : I_WU]) + (size_t)L * D * FF, D, FF, (bf16_t*)(F.ws + WS_WGU) + (size_t)L * (2 * FF) * D, kb * 64, n0, (n0 >> 7) * 256 + w * 128 + (n0 & 127), scr, F.lane);
            } else {
                const int nblk = D / 32, kb = q / nblk, nb = q % nblk;
                p0_transpose_item(((const float*)(GAS const float*)F.kp[I_WDN]) + (size_t)L * FF * D, FF, D, (bf16_t*)(F.ws + WS_WD) + (size_t)L * D * FF, kb * 64, nb * 32, nb * 32, scr, F.lane);
            }
            continue;
        }
        r -= N_FFN;
        if (r < N_REC) {
            const int j = r / (IT_WIN + IT_WOUT), q = r % (IT_WIN + IT_WOUT);
            if (q < IT_WIN) { const int nblk = FF / 32, kb = q / nblk, nb = q % nblk;
                p0_transpose_item(((const float*)(GAS const float*)F.kp[I_WIN]) + (size_t)j * D * FF, D, FF, (bf16_t*)(F.ws + WS_WIN) + (size_t)j * FF * D, kb * 64, nb * 32, nb * 32, scr, F.lane);
            } else { const int q2 = q - IT_WIN, nblk = D / 32, kb = q2 / nblk, nb = q2 % nblk;
                p0_transpose_item(((const float*)(GAS const float*)F.kp[I_WOUT]) + (size_t)j * DR * D, DR, D, (bf16_t*)(F.ws + WS_WOUT) + (size_t)j * D * DR, kb * 64, nb * 32, nb * 32, scr, F.lane); }
            continue;
        }
        r -= N_REC;
        {
            const int j = r / (IT_QKV + IT_WO), q = r % (IT_QKV + IT_WO);
            if (q < IT_QKV) { const int nblk = NQKV / 32, kb = q / nblk, nb = q % nblk, n0 = nb * 32;
                int drow = n0;
                if (n0 < NQK) { const int pn = n0 >> 8, rem = n0 & 255, hd = rem >> 7, d = rem & 127; drow = pn * 256 + (d >> 6) * 128 + hd * 64 + (d & 63); }
                p0_transpose_item(((const float*)(GAS const float*)F.kp[I_WQKV]) + (size_t)j * D * NQKV, D, NQKV, (bf16_t*)(F.ws + WS_WQKV) + (size_t)j * NQKV * D, kb * 64, n0, drow, scr, F.lane);
            } else { const int q2 = q - IT_QKV, nblk = D / 32, kb = q2 / nblk, nb = q2 % nblk;
                p0_transpose_item(((const float*)(GAS const float*)F.kp[I_WO]) + (size_t)j * D * D, D, D, (bf16_t*)(F.ws + WS_WO) + (size_t)j * D * D, kb * 64, nb * 32, nb * 32, scr, F.lane); }
        }
    }
}

template <int MODE>
__device__ __forceinline__ void phase_rows(Frame& F, int nrows, const float* gam, const float* bet, const float* modS, int off_sh, int off_sc) {
    relaunder(F);
    float* HA = (float*)(F.ws + WS_HA); bf16_t* U = (bf16_t*)(F.ws + WS_U);
    for (int row = F.gw; row < nrows; row += F.ngw) {
        const int r = row < ML ? (row >> 12) : 4;
        f32x4 v[8];
        if (MODE == 0) { const float* src = row < ML ? ((const float*)(GAS const float*)F.kp[I_X]) + (size_t)row * D : ((const float*)(GAS const float*)F.kp[I_CTX]) + (size_t)(row - ML) * D;
#pragma unroll
            for (int j = 0; j < 8; ++j) v[j] = *(const f32x4*)(src + 4 * F.lane + 256 * j);
        } else {
            float s = 0.f;
#pragma unroll
            for (int j = 0; j < 8; ++j) { v[j] = *(const f32x4*)(HA + (size_t)row * D + 4 * F.lane + 256 * j); s += (v[j][0] + v[j][1]) + (v[j][2] + v[j][3]); }
            const float mean = wave_sum(s) * (1.f / D); float q = 0.f;
#pragma unroll
            for (int j = 0; j < 8; ++j) { v[j] = v[j] - mean; q += (v[j][0] * v[j][0] + v[j][1] * v[j][1]) + (v[j][2] * v[j][2] + v[j][3] * v[j][3]); }
            const float rstd = 1.f / sqrtf(wave_sum(q) * (1.f / D) + LN_EPS);
#pragma unroll
            for (int j = 0; j < 8; ++j) { const f32x4 g = *(const f32x4*)(gam + 4 * F.lane + 256 * j), b = *(const f32x4*)(bet + 4 * F.lane + 256 * j); v[j] = v[j] * rstd * g + b; }
        }
        if (MODE == 2) {
#pragma unroll
            for (int j = 0; j < 8; ++j) *(f32x4*)(((float*)(GAS float*)F.kp[25]) + (size_t)row * D + 4 * F.lane + 256 * j) = v[j];
        } else {
            const float* ms = modS + (size_t)r * MODN;
#pragma unroll
            for (int j = 0; j < 8; ++j) { const int c = 4 * F.lane + 256 * j;
                *(f32x4*)(HA + (size_t)row * D + c) = v[j] * ALPHA;
                const f32x4 sc = *(const f32x4*)(ms + off_sc + c), sh = *(const f32x4*)(ms + off_sh + c); const f32x4 u = v[j] * (sc + 1.0f) + sh;
                u32x2 w; w.x = cvt_pk_bf16(u[0], u[1]); w.y = cvt_pk_bf16(u[2], u[3]); *(u32x2*)(U + (size_t)row * D + c) = w; }
        }
    }
}

__device__ __forceinline__ void phase_conv(Frame& F, int j) {
    relaunder(F);
    const bf16_t* P = (const bf16_t*)(F.ws + WS_BIG); bf16_t* Z = (bf16_t*)(F.ws + WS_Z);
    const float* cw = ((const float*)(GAS const float*)F.kp[I_CONVW]) + (size_t)j * 4 * DR; const float* cb = ((const float*)(GAS const float*)F.kp[I_CONVB]) + (size_t)j * DR;
    constexpr int RCH = 16, NITEMS = (MT / RCH) * 6;
    for (int it = F.gw; it < NITEMS; it += F.ngw) {
        const int rc = it / 6, cbk = it % 6, row0 = rc * RCH;
        const int pc0 = cbk * 512 + F.lane * 8, hb = pc0 / 192, i0 = pc0 % 192; const bool valid = i0 < BW; const int ch = hb * BW + i0;
        const int seq_lo = row0 < ML ? (row0 & ~(SEQ - 1)) : (ML + ((row0 - ML) & ~(CTXL - 1))), seq_hi = seq_lo + (row0 < ML ? SEQ : CTXL);
        float w[4][8], bias[8];
#pragma unroll
        for (int e = 0; e < 8; ++e) { bias[e] = valid ? cb[ch + e] : 0.f;
#pragma unroll
            for (int t = 0; t < 4; ++t) w[t][e] = valid ? cw[t * DR + ch + e] : 0.f; }
        const bf16_t* src = P + DR + ch;
        auto ld = [&](int row) -> u32x4 { u32x4 z = {0u, 0u, 0u, 0u}; if (valid && row >= seq_lo && row < seq_hi) z = *(const u32x4*)(src + (size_t)row * FF); return z; };
        u32x4 xm2 = ld(row0 - 2), xm1 = ld(row0 - 1), x0 = ld(row0);
        for (int i = 0; i < RCH; ++i) {
            const int row = row0 + i; const u32x4 xp1 = ld(row + 1);
            float o[8];
#pragma unroll
            for (int e = 0; e < 8; ++e) { const int wd = e >> 1; const bool hi = e & 1;
                const float a = hi ? bfhi(xm2[wd]) : bflo(xm2[wd]), b = hi ? bfhi(xm1[wd]) : bflo(xm1[wd]), c = hi ? bfhi(x0[wd]) : bflo(x0[wd]), d = hi ? bfhi(xp1[wd]) : bflo(xp1[wd]);
                o[e] = bias[e] + w[0][e] * a + w[1][e] * b + w[2][e] * c + w[3][e] * d; }
            u32x4 ov; ov.x = cvt_pk_bf16(o[0], o[1]); ov.y = cvt_pk_bf16(o[2], o[3]); ov.z = cvt_pk_bf16(o[4], o[5]); ov.w = cvt_pk_bf16(o[6], o[7]);
            *(u32x4*)(Z + (size_t)row * ZP + pc0) = ov;
            xm2 = xm1; xm1 = x0; x0 = xp1;
        }
    }
}

template <int CTRL> __device__ __forceinline__ float dpp_f(float old, float v) {
    return __builtin_bit_cast(float, __builtin_amdgcn_update_dpp(__builtin_bit_cast(int, old), __builtin_bit_cast(int, v), CTRL, 0xf, 0xf, false));
}
template <int REV> __device__ __forceinline__ void row_scan(float& P, float& H) {
#define RS_STEP(C) { const float hs = dpp_f<C>(0.f, H), ps = dpp_f<C>(1.f, P); H = fmaf(P, hs, H); P = P * ps; }
    if (REV == 0) { RS_STEP(0x111) RS_STEP(0x112) RS_STEP(0x114) RS_STEP(0x118) }
    else          { RS_STEP(0x101) RS_STEP(0x102) RS_STEP(0x104) RS_STEP(0x108) }
#undef RS_STEP
}
template <int DIR>
__device__ __forceinline__ void rec_sweep(Frame& F, int j, int b, int hb, int ct) {
    const int lane = F.lane, fr = lane & 15, fq = lane >> 4;
    const bf16_t* Z = (const bf16_t*)(F.ws + WS_Z); const bf16_t* P = (const bf16_t*)(F.ws + WS_BIG); float* HF = (float*)(F.ws + WS_HF); bf16_t* V = (bf16_t*)(F.ws + WS_V);
    const size_t wbase = ((size_t)(j * 2 + DIR) * 16 + hb) * BW * BW;
    const float* Wa = ((const float*)(GAS const float*)F.kp[I_GAW]) + wbase; const float* Wx = ((const float*)(GAS const float*)F.kp[I_GXW]) + wbase;
    bf16x8 Af[2][6];
    const int oc = ct * 16 + fr;
#pragma unroll
    for (int ks = 0; ks < 6; ++ks) { float va[8], vx[8];
#pragma unroll
        for (int jj = 0; jj < 8; ++jj) { const int i = ks * 32 + 8 * fq + jj; const bool ok = i < BW; va[jj] = ok ? Wa[(size_t)i * BW + oc] : 0.f; vx[jj] = ok ? Wx[(size_t)i * BW + oc] : 0.f; }
        u32x4 pa, px; pa.x = cvt_pk_bf16(va[0], va[1]); pa.y = cvt_pk_bf16(va[2], va[3]); pa.z = cvt_pk_bf16(va[4], va[5]); pa.w = cvt_pk_bf16(va[6], va[7]);
        px.x = cvt_pk_bf16(vx[0], vx[1]); px.y = cvt_pk_bf16(vx[2], vx[3]); px.z = cvt_pk_bf16(vx[4], vx[5]); px.w = cvt_pk_bf16(vx[6], vx[7]);
        Af[0][ks] = __builtin_bit_cast(bf16x8, pa); Af[1][ks] = __builtin_bit_cast(bf16x8, px); }
    const int cg = hb * BW + ct * 16 + 4 * fq; const size_t pv = (size_t)(j * 2 + DIR) * DR + cg;
    const f32x4 ba = *(const f32x4*)(((const float*)(GAS const float*)F.kp[I_GAB]) + pv), bx = *(const f32x4*)(((const float*)(GAS const float*)F.kp[I_GXB]) + pv), lam = *(const f32x4*)(((const float*)(GAS const float*)F.kp[I_LAM]) + pv);
    f32x4 c1;
#pragma unroll
    for (int e = 0; e < 4; ++e) c1[e] = -8.0f * LOG2E * log1pf(expf(-lam[e]));
    f32x4 hst = {0.f, 0.f, 0.f, 0.f};
    const int zcol = hb * 192, ycol = cg;
    for (int s = 0; s < 272; ++s) {
        int row0;
        if (DIR == 0) row0 = s < 16 ? (ML + b * CTXL + 16 * s) : (b * SEQ + 16 * (s - 16));
        else          row0 = s < 16 ? (ML + b * CTXL + 16 * (15 - s)) : (b * SEQ + 16 * (255 - (s - 16)));
        const int row = row0 + fr;
        const bf16_t* zr = Z + (size_t)row * ZP + zcol;
        bf16x8 Bf[6];
#pragma unroll
        for (int ks = 0; ks < 6; ++ks) Bf[ks] = *(const bf16x8*)(zr + ks * 32 + 8 * fq);
        const u32x2 zz = *(const u32x2*)(zr + ct * 16 + 4 * fq);
        f32x4 hprev = {0.f, 0.f, 0.f, 0.f}; u32x2 yy = {0u, 0u};
        if (DIR == 1) { hprev = *(const f32x4*)(HF + (size_t)row * DR + cg); yy = *(const u32x2*)(P + (size_t)row * FF + ycol); }
        f32x4 aa = {0.f, 0.f, 0.f, 0.f}, ax = aa;
#pragma unroll
        for (int ks = 0; ks < 6; ++ks) { aa = __builtin_amdgcn_mfma_f32_16x16x32_bf16(Af[0][ks], Bf[ks], aa, 0, 0, 0); ax = __builtin_amdgcn_mfma_f32_16x16x32_bf16(Af[1][ks], Bf[ks], ax, 0, 0, 0); }
        const float zv[4] = {bflo(zz[0]), bfhi(zz[0]), bflo(zz[1]), bfhi(zz[1])};
        f32x4 hn;
#pragma unroll
        for (int e = 0; e < 4; ++e) {
            const float rg = sigmoid_fast(aa[e] + ba[e]), ig = sigmoid_fast(ax[e] + bx[e]);
            float Pv = __builtin_amdgcn_exp2f(c1[e] * rg);
            float Hv = __builtin_amdgcn_sqrtf(fmaxf(1.0f - Pv * Pv, 0.f)) * ig * zv[e];
            row_scan<DIR>(Pv, Hv);
            Hv = fmaf(Pv, hst[e], Hv);
            hn[e] = __shfl(Hv, (lane & 48) | (DIR == 0 ? 15 : 0));
            aa[e] = Hv;
        }
        hst = hn;
        if (DIR == 0) *(f32x4*)(HF + (size_t)row * DR + cg) = aa;
        else { const float yv[4] = {bflo(yy[0]), bfhi(yy[0]), bflo(yy[1]), bfhi(yy[1])};
            u32x2 o; o.x = cvt_pk_bf16(yv[0] * (aa[0] + hprev[0]), yv[1] * (aa[1] + hprev[1])); o.y = cvt_pk_bf16(yv[2] * (aa[2] + hprev[2]), yv[3] * (aa[3] + hprev[3]));
            *(u32x2*)(V + (size_t)row * DR + cg) = o; }
    }
}
__device__ __forceinline__ void phase_scan(Frame& F, int j) {
    relaunder(F);
    const int it = F.cu + 256 * F.wave;
    if (F.wave < 3 && it < NBATCH * 16 * 11) {
        const int b = it / 176, rem = it % 176, hb = rem / 11, ct = rem % 11;
        rec_sweep<0>(F, j, b, hb, ct);
        VM_WAIT();
        rec_sweep<1>(F, j, b, hb, ct);
    }
}

constexpr int ATT_KB = 16384, ATT_BUF = 2 * ATT_KB;
__device__ __forceinline__ int crow(int r, int hi) { return (r & 3) + 8 * (r >> 2) + 4 * hi; }
__device__ __forceinline__ void attn_unit(Frame& F, int b, int kvh, int qrow0, bool is_ctx, int q0, const float* sink) {
    const bf16_t* QK = (const bf16_t*)(F.ws + WS_BIG); const bf16_t* VT = (const bf16_t*)(F.ws + WS_HF); bf16_t* ATT = (bf16_t*)(F.ws + WS_Z);
    const int tid = F.tid, lane = F.lane, wave = F.wave, r32 = lane & 31, hi = lane >> 5;
    const int head = kvh * 4 + (wave >> 1), qi = 32 * (wave & 1) + r32;
    const int qrow = qrow0 + qi;
    int jl = 0, nloc = 0;
    if (!is_ctx) { jl = q0 >= 128 ? 0 : (q0 >= 64 ? 1 : 2); const int jh = q0 <= SEQ - 192 ? 4 : (q0 <= SEQ - 128 ? 3 : 2); nloc = jh - jl + 1; }
    const int nt = nloc + 4;
    u32x4 kreg[2], vreg[2];
#define ATT_LOAD(t) do { const int t_ = (t); int krow0_; if (t_ < nloc) krow0_ = b * SEQ + q0 - 128 + 64 * (jl + t_); else krow0_ = ML + b * CTXL + 64 * (t_ - nloc); \
        _Pragma("unroll") for (int i_ = 0; i_ < 2; ++i_) { const int p_ = tid + 512 * i_; \
            kreg[i_] = *(const u32x4*)(QK + (size_t)(krow0_ + (p_ >> 4)) * NQK + 2048 + kvh * 128 + 8 * (p_ & 15)); \
            vreg[i_] = *(const u32x4*)(VT + (size_t)(kvh * 128 + (p_ >> 3)) * MT + krow0_ + 8 * (p_ & 7)); } } while (0)
#define ATT_STORE(buf) do { LAS unsigned char* kb_ = F.lds + (buf) * ATT_BUF; \
        _Pragma("unroll") for (int i_ = 0; i_ < 2; ++i_) { const int p_ = tid + 512 * i_; const int kr_ = p_ >> 4, kc_ = p_ & 15, vd_ = p_ >> 3, vc_ = p_ & 7; \
            *(LAS u32x4*)(kb_ + (kr_ * 16 + (kc_ ^ (kr_ & 15))) * 16) = kreg[i_]; \
            *(LAS u32x4*)(kb_ + ATT_KB + (vd_ * 8 + (vc_ ^ ((vd_ >> 1) & 7))) * 16) = vreg[i_]; } } while (0)
    ATT_LOAD(0);
    bf16x8 qf[8];
#pragma unroll
    for (int ds = 0; ds < 8; ++ds) qf[ds] = *(const bf16x8*)(QK + (size_t)qrow * NQK + head * 128 + 16 * ds + 8 * hi);
    const float sk2 = sink[head] * LOG2E;
    float mrun = sk2, lrun = hi == 0 ? 1.0f : 0.0f;
    f32x16 o[4];
#pragma unroll
    for (int d = 0; d < 4; ++d)
#pragma unroll
        for (int r = 0; r < 16; ++r) o[d][r] = 0.f;
    __syncthreads();
    ATT_STORE(0);
    __syncthreads();
    for (int t = 0; t < nt; ++t) {
        if (t + 1 < nt) ATT_LOAD(t + 1);
        const LAS unsigned char* kb = F.lds + (t & 1) * ATT_BUF; const LAS unsigned char* vb = kb + ATT_KB;
        f32x16 p[2];
#pragma unroll
        for (int hf = 0; hf < 2; ++hf) {
#pragma unroll
            for (int r = 0; r < 16; ++r) p[hf][r] = 0.f;
            const int kv = 32 * hf + r32;
#pragma unroll
            for (int ds = 0; ds < 8; ++ds) { const bf16x8 kf = *(const LAS bf16x8*)(kb + (kv * 16 + ((2 * ds + hi) ^ (kv & 15))) * 16);
                p[hf] = __builtin_amdgcn_mfma_f32_32x32x16_bf16(kf, qf[ds], p[hf], 0, 0, 0); }
        }
        const int jt = t < nloc ? jl + t : -1;
        if (jt == 0 || jt == 4) {
#pragma unroll
            for (int hf = 0; hf < 2; ++hf)
#pragma unroll
                for (int r = 0; r < 16; ++r) { const int kvi = 32 * hf + crow(r, hi); const bool ok = jt == 0 ? (kvi >= qi) : (kvi <= qi); if (!ok) p[hf][r] = -1e30f; }
        }
        float tm = p[0][0];
#pragma unroll
        for (int hf = 0; hf < 2; ++hf)
#pragma unroll
            for (int r = 0; r < 16; ++r) tm = fmaxf(tm, p[hf][r]);
        tm = fmaxf(tm, __shfl_xor(tm, 32));
        const float mnew = fmaxf(mrun, tm), sc = __builtin_amdgcn_exp2f(mrun - mnew);
        mrun = mnew; lrun *= sc;
#pragma unroll
        for (int d = 0; d < 4; ++d)
#pragma unroll
            for (int r = 0; r < 16; ++r) o[d][r] *= sc;
        float ls = 0.f;
#pragma unroll
        for (int hf = 0; hf < 2; ++hf)
#pragma unroll
            for (int r = 0; r < 16; ++r) { const float e = __builtin_amdgcn_exp2f(p[hf][r] - mnew); p[hf][r] = e; ls += e; }
        lrun += ls;
#pragma unroll
        for (int s = 0; s < 4; ++s) {
            const int hf = s >> 1, rb = 8 * (s & 1);
            u32x4 pw; pw.x = cvt_pk_bf16(p[hf][rb + 0], p[hf][rb + 1]); pw.y = cvt_pk_bf16(p[hf][rb + 2], p[hf][rb + 3]); pw.z = cvt_pk_bf16(p[hf][rb + 4], p[hf][rb + 5]); pw.w = cvt_pk_bf16(p[hf][rb + 6], p[hf][rb + 7]);
            const bf16x8 pf = __builtin_bit_cast(bf16x8, pw);
#pragma unroll
            for (int db = 0; db < 4; ++db) { const int d = 32 * db + r32; const int sw = (d >> 1) & 7;
                const int ua = 4 * s + hi, ub = 4 * s + 2 + hi;
                const u32x2 va = *(const LAS u32x2*)(vb + (d * 8 + ((ua >> 1) ^ sw)) * 16 + (ua & 1) * 8);
                const u32x2 vc = *(const LAS u32x2*)(vb + (d * 8 + ((ub >> 1) ^ sw)) * 16 + (ub & 1) * 8);
                u32x4 vw; vw.x = va.x; vw.y = va.y; vw.z = vc.x; vw.w = vc.y;
                o[db] = __builtin_amdgcn_mfma_f32_32x32x16_bf16(__builtin_bit_cast(bf16x8, vw), pf, o[db], 0, 0, 0); }
        }
        if (t + 1 < nt) ATT_STORE((t + 1) & 1);
        __syncthreads();
    }
    const float ltot = lrun + __shfl_xor(lrun, 32); const float inv = 1.0f / ltot;
    bf16_t* op = ATT + (size_t)qrow * D + head * 128;
#pragma unroll
    for (int db = 0; db < 4; ++db)
#pragma unroll
        for (int g = 0; g < 4; ++g) { u32x2 w; w.x = cvt_pk_bf16(o[db][4 * g] * inv, o[db][4 * g + 1] * inv); w.y = cvt_pk_bf16(o[db][4 * g + 2] * inv, o[db][4 * g + 3] * inv);
            *(u32x2*)(op + 32 * db + 8 * g + 4 * hi) = w; }
#undef ATT_LOAD
#undef ATT_STORE
}
__device__ __forceinline__ void phase_attn(Frame& F, int j, bool ctx_out) {
    relaunder(F);
    const float* sink = ((const float*)(GAS const float*)F.kp[I_SINK]) + j * 16;
    const int nunits = 1024 + (ctx_out ? 64 : 0);
    for (int u = F.cu; u < nunits; u += F.G) {
        if (u < 1024) { const int b = u >> 8, kvh = (u >> 6) & 3, qb = u & 63; attn_unit(F, b, kvh, b * SEQ + 64 * qb, false, 64 * qb, sink); }
        else { const int v = u - 1024, b = v >> 4, kvh = (v >> 2) & 3, qc = v & 3; attn_unit(F, b, kvh, ML + b * CTXL + 64 * qc, true, 0, sink); }
    }
}

#ifndef MK_PER_PHASE
#define MK_PER_PHASE 0
#endif
constexpr int NPHASE = 2 + 10 * DEPTH;
#ifndef EN
#define EN 0xffff
#endif
struct Args { const float* in[25]; float* out; unsigned char* ws; int ph_lo, ph_hi; };
__global__ void __launch_bounds__(NWAVES * 64, 2) fwd_kernel(Args args) {
    extern __shared__ __attribute__((aligned(16))) unsigned char lds[];
    Frame F;
    F.lds = (LAS unsigned char*)lds;
    F.tid = threadIdx.x; F.lane = F.tid & 63; F.wave = __builtin_amdgcn_readfirstlane(F.tid >> 6);
    F.G = gridDim.x; F.gw = blockIdx.x * NWAVES + F.wave; F.ngw = F.G * NWAVES;
    F.kp = kargs(); F.ws = (unsigned char*)(GAS unsigned char*)F.kp[26]; F.cu = blockIdx.x;
    volatile LAS unsigned* MISC = (volatile LAS unsigned*)(F.lds + MISC_OFF);
    for (int u = F.tid; u < (LDS_BYTES - LDSCTL_OFF) / 4; u += NWAVES * 64) ((LAS unsigned*)(F.lds + LDSCTL_OFF))[u] = 0u;
    __syncthreads();
    XcdBarrier bar = xcd_barrier_post((unsigned*)(F.ws + WS_CTL) + CW_BAR, MISC + 8);
#if MK_PER_PHASE
    const int lo = (int)(unsigned)F.kp[27], hi = (int)(unsigned)(F.kp[27] >> 32);
#define IN(k) (lo <= (k) && (k) < hi)
#define SEAM() do { } while (0)
#else
#define IN(k) true
#define SEAM() xcd_barrier(bar)
#endif
#define modv ((float*)(F.ws + WS_MODV))
#define U ((bf16_t*)(F.ws + WS_U))
#define BIG ((bf16_t*)(F.ws + WS_BIG))
#define HA ((float*)(F.ws + WS_HA))
#define cu (F.cu)
#define modL (modv + (size_t)L * 5 * MODN)

    if (IN(0)) { if (EN&1) phase_p0a(F); SEAM(); }
    if (IN(1)) { if (EN&2) phase_rows<0>(F, MT, nullptr, nullptr, modv, 0, D); SEAM(); }
    for (int L = 0; L < DEPTH; ++L) {
        const int base = 2 + 10 * L, j = L >> 1; const bool last = (L == DEPTH - 1), rec = (L & 1) == 0; const int Mrows = last ? ML : MT;
        if (IN(base + 0)) {
            if (rec) { if (EN&4) { relaunder(F);
                pg8::Gemm g{U, (const bf16_t*)(F.ws + WS_WIN) + (size_t)j * FF * D, MT, FF, D}; pg8::StaticOrder S; S.init(MT, FF, F.G, cu);
                pg8::EpiBf16 E{BIG, FF, 11};
                pg8::gemm_phase<pg8::EpiBf16, pg8::StaticOrder, PG8_ALIGN, PG8_SP2>(F.lds + RING_OFF, g, S, E); }
            } else {
                if (EN&8) { relaunder(F); const bf16_t* Wq = (const bf16_t*)(F.ws + WS_WQKV) + (size_t)j * NQKV * D; pg8::Gemm g{U, Wq, MT, NQK, D}; pg8::StaticOrder S; S.init(MT, NQK, F.G, cu);
                  pg8::EpiQK E{BIG, (const f32x2*)(F.ws + WS_ROPE)};
                  pg8::gemm_phase<pg8::EpiQK, pg8::StaticOrder, PG8_ALIGN, PG8_SP2>(F.lds + RING_OFF, g, S, E); }
                if (EN&16) { relaunder(F); const bf16_t* Wq = (const bf16_t*)(F.ws + WS_WQKV) + (size_t)j * NQKV * D; pg8::Gemm g{Wq + (size_t)NQK * D, U, NVV, MT, D}; pg8::StaticOrder S; S.init(NVV, MT, F.G, (cu + 88) & 255);
                  pg8::EpiBf16 E{(bf16_t*)(F.ws + WS_HF), MT, 0};
                  pg8::gemm_phase<pg8::EpiBf16, pg8::StaticOrder, PG8_ALIGN, PG8_SP2>(F.lds + RING_OFF, g, S, E); }
            }
            SEAM();
        }
        if (rec) {
            if (IN(base + 1)) { if (EN&32) phase_conv(F, j); SEAM(); }
            if (IN(base + 2)) { if (EN&64) phase_scan(F, j); SEAM(); }
        } else {
            if (IN(base + 2)) { if (EN&128) phase_attn(F, j, !last); SEAM(); }
        }
        if (IN(base + 3)) { if (EN&256) { relaunder(F);
            pg8::Gemm g; if (rec) g = pg8::Gemm{(const bf16_t*)(F.ws + WS_V), (const bf16_t*)(F.ws + WS_WOUT) + (size_t)j * D * DR, Mrows, D, DR};
            else g = pg8::Gemm{(const bf16_t*)(F.ws + WS_Z), (const bf16_t*)(F.ws + WS_WO) + (size_t)j * D * D, Mrows, D, D};
            pg8::StaticOrder S; S.init(Mrows, D, F.G, cu);
            pg8::EpiRes E{HA, D, modL + 2 * D, MODN};
            pg8::gemm_phase<pg8::EpiRes, pg8::StaticOrder, PG8_ALIGN, PG8_SP2>(F.lds + RING_OFF, g, S, E); }
            SEAM();
        }
        if (IN(base + 4)) { if (EN&512) phase_rows<1>(F, Mrows, ((const float*)(GAS const float*)F.kp[I_LNMG]) + (size_t)L * D, ((const float*)(GAS const float*)F.kp[I_LNMB]) + (size_t)L * D, modL, 3 * D, 4 * D); SEAM(); }
        if (IN(base + 5)) { if (EN&1024) { relaunder(F);
            pg8::Gemm g{U, (const bf16_t*)(F.ws + WS_WGU) + (size_t)L * (2 * FF) * D, Mrows, 2 * FF, D}; pg8::StaticOrder S; S.init(Mrows, 2 * FF, F.G, cu);
            pg8::EpiGU E{BIG, FF};
            pg8::gemm_phase<pg8::EpiGU, pg8::StaticOrder, PG8_ALIGN, PG8_SP2>(F.lds + RING_OFF, g, S, E); }
            SEAM();
        }
        if (IN(base + 6)) { if (EN&2048) { relaunder(F);
            pg8::Gemm g{BIG, (const bf16_t*)(F.ws + WS_WD) + (size_t)L * D * FF, Mrows, D, FF}; pg8::StaticOrder S; S.init(Mrows, D, F.G, cu);
            pg8::EpiRes E{HA, D, modL + 5 * D, MODN};
            pg8::gemm_phase<pg8::EpiRes, pg8::StaticOrder, PG8_ALIGN, PG8_SP2>(F.lds + RING_OFF, g, S, E); }
            SEAM();
        }
        if (IN(base + 7)) { if (EN&4096) {
            if (last) phase_rows<2>(F, ML, ((const float*)(GAS const float*)F.kp[I_LNFG]) + (size_t)L * D, ((const float*)(GAS const float*)F.kp[I_LNFB]) + (size_t)L * D, nullptr, 0, 0);
            else { phase_rows<1>(F, MT, ((const float*)(GAS const float*)F.kp[I_LNFG]) + (size_t)L * D, ((const float*)(GAS const float*)F.kp[I_LNFB]) + (size_t)L * D, modv + (size_t)(L + 1) * 5 * MODN, 0, D); } }
            if (!last) SEAM();
        }
    }
#undef IN
#undef SEAM
#undef modv
#undef U
#undef BIG
#undef HA
#undef cu
#undef modL
}

extern "C" void kernel_launch(void* const* d_in, const int* in_sizes, int n_in, void* d_out, int out_size, void* d_ws, size_t ws_size, hipStream_t stream) {
    static int grid = 0;
    if (grid == 0) {
        if (n_in != 25 || out_size != ML * D || ws_size < WS_END) { fprintf(stderr, "kernel_launch: unexpected shapes / workspace (n_in %d out %d ws %zu need %zu)\n", n_in, out_size, ws_size, (size_t)WS_END); grid = -1; return; }
        int dev = 0, cus = 0;
        if (hipGetDevice(&dev) != hipSuccess || hipDeviceGetAttribute(&cus, hipDeviceAttributeMultiprocessorCount, dev) != hipSuccess) { grid = -1; return; }
        if (hipFuncSetAttribute((const void*)fwd_kernel, hipFuncAttributeMaxDynamicSharedMemorySize, LDS_BYTES) != hipSuccess) { fprintf(stderr, "kernel_launch: hipFuncSetAttribute failed\n"); grid = -1; return; }
        int per_cu = 0;
        if (hipOccupancyMaxActiveBlocksPerMultiprocessor(&per_cu, (const void*)fwd_kernel, NWAVES * 64, LDS_BYTES) != hipSuccess || per_cu < 1) { fprintf(stderr, "kernel_launch: occupancy query says %d\n", per_cu); }
        (void)hipGetLastError();
        grid = cus < 256 ? cus : 256;
    }
    if (grid < 0) return;
    if (hipMemsetAsync((char*)d_ws + WS_CTL, 0, CTL_ZERO_BYTES, stream) != hipSuccess) return;
    Args a{};
    for (int i = 0; i < 25; ++i) a.in[i] = (const float*)d_in[i];
    a.out = (float*)d_out; a.ws = (unsigned char*)d_ws;
#if MK_PER_PHASE
    for (int p = 0; p < NPHASE; ++p) { a.ph_lo = p; a.ph_hi = p + 1; hipLaunchKernelGGL(fwd_kernel, dim3(grid), dim3(NWAVES * 64), LDS_BYTES, stream, a); }
#else
    a.ph_lo = 0; a.ph_hi = NPHASE;
    hipLaunchKernelGGL(fwd_kernel, dim3(grid), dim3(NWAVES * 64), LDS_BYTES, stream, a);
#endif
    const hipError_t le = hipPeekAtLastError();
    if (le != hipSuccess) fprintf(stderr, "kernel_launch: launch failed: %s\n", hipGetErrorName(le));
}
```

```cpp
#include <hip/hip_runtime.h>
#include <cstdint>
#include <cstdio>

#define LAS __attribute__((address_space(3)))
#define GAS __attribute__((address_space(1)))
typedef unsigned short bf16_t;
typedef short bf16x8 __attribute__((ext_vector_type(8)));
typedef short bf16x4 __attribute__((ext_vector_type(4)));
typedef float f32x4 __attribute__((ext_vector_type(4)));
typedef float f32x2 __attribute__((ext_vector_type(2)));
typedef float f32x16 __attribute__((ext_vector_type(16)));
typedef unsigned u32x4 __attribute__((ext_vector_type(4)));
typedef unsigned u32x2 __attribute__((ext_vector_type(2)));

constexpr int D = 2048, SEQ = 4096, CTXL = 256, NBATCH = 4, ML = NBATCH * SEQ, MC = NBATCH * CTXL, MT = ML + MC;
constexpr int DR = 2816, FF = 5632, NQK = 2560, NVV = 512, NQKV = 3072, MODN = 6 * D, DEPTH = 4, BW = 176, ZP = 3072, NWAVES = 8;
constexpr float ALPHA = 1.6817928305074292f, LN_EPS = 1e-5f, LOG2E = 1.4426950408889634f;
constexpr float QSCALE = 0.08838834764831845f * 1.4426950408889634f;

constexpr size_t MiB = 1u << 20;
constexpr size_t WS_CTL = 0, CTL_ZERO_BYTES = 1 * MiB;
constexpr size_t WS_MODV = 1 * MiB, WS_ROPE = 2 * MiB, WS_STATS = 3 * MiB;
constexpr size_t WS_WGU = 4 * MiB;
constexpr size_t WS_WD = WS_WGU + 4 * (size_t)(2 * FF) * D * 2;
constexpr size_t WS_WIN = WS_WD + 4 * (size_t)D * FF * 2;
constexpr size_t WS_WOUT = WS_WIN + 2 * (size_t)FF * D * 2;
constexpr size_t WS_WQKV = WS_WOUT + 2 * (size_t)D * DR * 2;
constexpr size_t WS_WO = WS_WQKV + 2 * (size_t)NQKV * D * 2;
constexpr size_t WS_HA = WS_WO + 2 * (size_t)D * D * 2;
constexpr size_t WS_U = WS_HA + (size_t)MT * D * 4;
constexpr size_t WS_BIG = WS_U + (size_t)MT * D * 2;
constexpr size_t WS_Z = WS_BIG + (size_t)MT * FF * 2;
constexpr size_t WS_V = WS_Z + (size_t)MT * ZP * 2;
constexpr size_t WS_HF = WS_V + (size_t)MT * DR * 2;
constexpr size_t WS_SLAB = WS_HF + (size_t)MT * DR * 4;
constexpr size_t WS_END = WS_SLAB + 8 * (size_t)MC * D * 4;
namespace pg8 {
#define PG8_LAS __attribute__((address_space(3)))
typedef unsigned short bf16_t;
typedef short bf16x8 __attribute__((ext_vector_type(8)));
typedef float f32x4 __attribute__((ext_vector_type(4)));
typedef unsigned u32x4 __attribute__((ext_vector_type(4)));
constexpr int BM = 256, BK = 64, HALF = 128, HTB = HALF * BK * 2  , STAGE_BYTES = 8 * HTB, NXCD = 8, WGM = 8;

__host__ __device__ __forceinline__ int lds_byte(int r, int c) { const int st = (r >> 4) * 2 + (c >> 5), rr = r & 15, cc = c & 31, ob = rr * 64 + cc * 2; return st * 1024 + (ob ^ (((ob >> 9) & 1) << 5)); }
__host__ __device__ __forceinline__ void stage_rc(int b, int& R, int& C) { const int st = b / 1024, sb = b % 1024, swz = sb ^ (((sb >> 9) & 1) << 5); R = (st >> 1) * 16 + swz / 64; C = (st & 1) * 32 + (swz % 64) / 2; }
__host__ __device__ __forceinline__ int perm32(int rho) { const int n = rho >> 4, i = rho & 15; return 8 * (i >> 2) + 4 * n + (i & 3); }

struct Unit { int pm, pn, kt0, nt, q; };
struct Gemm { const bf16_t* A; const bf16_t* Bt; int M, N, K; };

struct StaticOrder {
    int nM, nN, nwg, G, c;
    __host__ __device__ void init(int M, int N, int G_, int c_) { nM = M / BM; nN = N / BM; nwg = nM * nN; G = G_; c = c_; }
    __host__ __device__ __forceinline__ bool next(int i, Unit& u) const {
        u.kt0 = 0; u.nt = 0; u.q = 0; u.pm = 0; u.pn = 0;
        const long L = (long)i * G + c; if (L >= nwg) return false;
        int wgid = (int)L; { const int q = nwg / NXCD, r = nwg % NXCD, xcd = wgid % NXCD, off = wgid / NXCD; wgid = (xcd < r ? xcd * (q + 1) : r * (q + 1) + (xcd - r) * q) + off; }
        const int nig = WGM * nN, gid = wgid / nig, fm = gid * WGM, gsz = (nM - fm) < WGM ? (nM - fm) : WGM;
        u.pm = fm + ((wgid % nig) % gsz); u.pn = (wgid % nig) / gsz; u.kt0 = 0; u.nt = 0; u.q = 0; return true;
    }
    __device__ __forceinline__ void a_ready(const Unit&) const {}
    __device__ __forceinline__ void done(const Unit&) const {}
};

struct TailOrder {
    StaticOrder S; int c, T; bool tail;
    __host__ __device__ void init(int N, int K, int G_, int c_, bool tail_) { S.init(ML, N, G_, c_); c = c_; T = K / BK; tail = tail_; }
    __device__ __forceinline__ bool next(int i, Unit& u) const {
        Unit v; const bool okS = S.next(i < 2 ? i : 0, v);
        const int tile = c >> 3, q = c & 7, be = (T >> 3) & ~1, rem2 = (T - 8 * be) >> 1;
        const bool isTail = (i == 2) && tail;
        u.pm = isTail ? 64 + (tile >> 3) : v.pm; u.pn = isTail ? (tile & 7) : v.pn;
        u.nt = isTail ? be + (q < rem2 ? 2 : 0) : 0; u.kt0 = isTail ? q * be + 2 * (q < rem2 ? q : rem2) : 0; u.q = isTail ? q : 0;
        return i < 2 ? okS : isTail;
    }
    __device__ __forceinline__ void a_ready(const Unit&) const {}
    __device__ __forceinline__ void done(const Unit&) const {}
};

typedef __bf16 bf16x2_t __attribute__((ext_vector_type(2))); typedef float f32x2_t __attribute__((ext_vector_type(2)));
__device__ __forceinline__ unsigned cvt_pk_bf16(float lo, float hi) { f32x2_t v = {lo, hi}; bf16x2_t b = __builtin_convertvector(v, bf16x2_t); return __builtin_bit_cast(unsigned, b); }
__device__ __forceinline__ float sigmoid_fast(float x) { return __builtin_amdgcn_rcpf(1.0f + __builtin_amdgcn_exp2f(-1.4426950408889634f * x)); }
__device__ __forceinline__ float gelu_tanh_fast(float x) { const float y = x * (1.5957691216057308f + 0.07135481627159498f * x * x); return x * sigmoid_fast(y); }
__device__ __forceinline__ u32x4 pack8(const f32x4 a, const f32x4 b) { u32x4 w; w.x = cvt_pk_bf16(a[0], a[1]); w.y = cvt_pk_bf16(a[2], a[3]); w.z = cvt_pk_bf16(b[0], b[1]); w.w = cvt_pk_bf16(b[2], b[3]); return w; }

struct EpiBf16 {
    static constexpr bool PERM = true, AFTER_DRAIN = false;
    bf16_t* O; int ldc; int gelu_tiles;
    __device__ __forceinline__ void operator()(const f32x4 (&acc)[2][2][4][2], const Unit& u, int wr, int wc, int fr, int fq) const {
        const int row0 = u.pm * BM + wr * 64 + fr, col0 = u.pn * BM + wc * 32 + 8 * fq; const bool act = u.pn < gelu_tiles;
#pragma unroll
        for (int ai = 0; ai < 2; ++ai)
#pragma unroll
            for (int m = 0; m < 4; ++m) { bf16_t* rowp = O + (size_t)(row0 + ai * HALF + m * 16) * ldc + col0;
#pragma unroll
                for (int bj = 0; bj < 2; ++bj) { f32x4 v0 = acc[ai][bj][m][0], v1 = acc[ai][bj][m][1];
                    if (act) {
#pragma unroll
                        for (int e = 0; e < 4; ++e) { v0[e] = gelu_tanh_fast(v0[e]); v1[e] = gelu_tanh_fast(v1[e]); } }
                    *(u32x4*)(rowp + bj * HALF) = pack8(v0, v1); } }
    }
};
struct EpiGU {
    static constexpr bool PERM = true, AFTER_DRAIN = false;
    bf16_t* O; int ldc;
    __device__ __forceinline__ void operator()(const f32x4 (&acc)[2][2][4][2], const Unit& u, int wr, int wc, int fr, int fq) const {
        const int row0 = u.pm * BM + wr * 64 + fr, col0 = u.pn * HALF + wc * 32 + 8 * fq;
#pragma unroll
        for (int ai = 0; ai < 2; ++ai)
#pragma unroll
            for (int m = 0; m < 4; ++m) { f32x4 o0, o1;
#pragma unroll
                for (int e = 0; e < 4; ++e) { const float g0 = acc[ai][0][m][0][e], g1 = acc[ai][0][m][1][e];
                    o0[e] = g0 * sigmoid_fast(g0) * acc[ai][1][m][0][e]; o1[e] = g1 * sigmoid_fast(g1) * acc[ai][1][m][1][e]; }
                *(u32x4*)(O + (size_t)(row0 + ai * HALF + m * 16) * ldc + col0) = pack8(o0, o1); }
    }
};
struct EpiRes {
    static constexpr bool PERM = false, AFTER_DRAIN = false;
    float* HA; int ldc; const float* gate;
    int gate_ld; float* slab;
    const float* src; const float* stats; const float* gam; const float* bet;
    __device__ __forceinline__ void operator()(const f32x4 (&acc)[2][2][4][2], const Unit& u, int wr, int wc, int fr, int fq) const {
        const int col0 = u.pn * BM + wc * 32 + 4 * fq;
        if (u.nt != 0) {
#pragma unroll
            for (int ai = 0; ai < 2; ++ai)
#pragma unroll
                for (int m = 0; m < 4; ++m) { float* p = slab + ((size_t)u.q * MC + (size_t)((u.pm - 64) * BM + ai * HALF + wr * 64 + m * 16 + fr)) * ldc + col0;
#pragma unroll
                    for (int bj = 0; bj < 2; ++bj)
#pragma unroll
                        for (int n = 0; n < 2; ++n) *(f32x4*)(p + bj * HALF + n * 16) = acc[ai][bj][m][n]; }
            return;
        }
        const int r = u.pm < 64 ? (u.pm >> 4) : 4; const float* g = gate + (size_t)r * gate_ld + col0;
        f32x4 gv[2][2], ga[2][2], be[2][2]; const bool ln = stats != nullptr;
#pragma unroll
        for (int bj = 0; bj < 2; ++bj)
#pragma unroll
            for (int n = 0; n < 2; ++n) { gv[bj][n] = *(const f32x4*)(g + bj * HALF + n * 16);
                ga[bj][n] = ln ? *(const f32x4*)(gam + col0 + bj * HALF + n * 16) * 1.6817928305074292f : (f32x4){1.6817928305074292f, 1.6817928305074292f, 1.6817928305074292f, 1.6817928305074292f};
                be[bj][n] = ln ? *(const f32x4*)(bet + col0 + bj * HALF + n * 16) * 1.6817928305074292f : (f32x4){0.f, 0.f, 0.f, 0.f}; }
#pragma unroll
        for (int ai = 0; ai < 2; ++ai)
#pragma unroll
            for (int m = 0; m < 4; ++m) { const size_t ro = (size_t)(u.pm * BM + ai * HALF + wr * 64 + m * 16 + fr); const float* sp = src + ro * ldc + col0; float* p = HA + ro * ldc + col0; f32x4 hv[2][2];
                float mean = 0.f, rstd = 1.f; if (ln) { const f32x2_t st = *(const f32x2_t*)(stats + 2 * ro); mean = st.x; rstd = st.y; }
#pragma unroll
                for (int bj = 0; bj < 2; ++bj)
#pragma unroll
                    for (int n = 0; n < 2; ++n) hv[bj][n] = *(const f32x4*)(sp + bj * HALF + n * 16);
#pragma unroll
                for (int bj = 0; bj < 2; ++bj)
#pragma unroll
                    for (int n = 0; n < 2; ++n) *(f32x4*)(p + bj * HALF + n * 16) = (hv[bj][n] - mean) * rstd * ga[bj][n] + be[bj][n] + gv[bj][n] * acc[ai][bj][m][n];
                if (m & 1) asm volatile("" ::: "memory"); }
    }
};
struct EpiQK {
    static constexpr bool PERM = true, AFTER_DRAIN = false;
    bf16_t* O; const f32x2* tab;
    __device__ __forceinline__ void operator()(const f32x4 (&acc)[2][2][4][2], const Unit& u, int wr, int wc, int fr, int fq) const {
        const int row0 = u.pm * BM + wr * 64 + fr; const bool latent = u.pm < 64; const float qs = u.pn < 8 ? 0.12751743082459868f : 1.0f;
        const int colA = u.pn * BM + (wc >> 1) * HALF + 32 * (wc & 1) + 8 * fq;
#pragma unroll
        for (int ai = 0; ai < 2; ++ai)
#pragma unroll
            for (int m = 0; m < 4; ++m) { const int row = row0 + ai * HALF + m * 16; const int t = row & 4095; const int pos = (wc & 1) ? (t & 63) : (t >> 6);
                const f32x4* tp = (const f32x4*)(tab + pos * 32 + 8 * fq); f32x4 o1[2], o2[2];
#pragma unroll
                for (int n = 0; n < 2; ++n) { f32x4 cs0 = (f32x4){1.f, 0.f, 1.f, 0.f}, cs1 = cs0;
                    if (latent) { cs0 = tp[2 * n]; cs1 = tp[2 * n + 1]; }
                    const f32x4 t1 = acc[ai][0][m][n], t2 = acc[ai][1][m][n];
                    o1[n][0] = (t1[0] * cs0[0] - t2[0] * cs0[1]) * qs; o2[n][0] = (t2[0] * cs0[0] + t1[0] * cs0[1]) * qs;
                    o1[n][1] = (t1[1] * cs0[2] - t2[1] * cs0[3]) * qs; o2[n][1] = (t2[1] * cs0[2] + t1[1] * cs0[3]) * qs;
                    o1[n][2] = (t1[2] * cs1[0] - t2[2] * cs1[1]) * qs; o2[n][2] = (t2[2] * cs1[0] + t1[2] * cs1[1]) * qs;
                    o1[n][3] = (t1[3] * cs1[2] - t2[3] * cs1[3]) * qs; o2[n][3] = (t2[3] * cs1[2] + t1[3] * cs1[3]) * qs; }
                bf16_t* rowp = O + (size_t)row * NQK + colA;
                *(u32x4*)(rowp) = pack8(o1[0], o1[1]); *(u32x4*)(rowp + 64) = pack8(o2[0], o2[1]); }
    }
};

template <class Epi, class Sched, bool ALIGN_EPI = false, bool SP2 = false>
__device__ __forceinline__ void gemm_phase(PG8_LAS unsigned char* lds, const Gemm g, const Sched& S, const Epi& E) {
    int tid_ = threadIdx.x; asm volatile("" : "+v"(tid_));
    const int tid = tid_, wid = __builtin_amdgcn_readfirstlane(tid >> 6), lane = tid & 63, wr = wid >> 2, wc = wid & 3, fr = lane & 15, fq = lane >> 4;
    const int K = g.K, nt = K / BK;
    unsigned voffA[2], voffB[2];
#pragma unroll
    for (int i = 0; i < 2; ++i) { int R, C; stage_rc(tid * 16 + i * 8192, R, C); const int Rb = Epi::PERM ? ((R & ~31) + perm32(R & 31)) : R;
        voffA[i] = (unsigned)(R * K + C) * 2u; voffB[i] = (unsigned)(Rb * K + C) * 2u; }
    const size_t kstep = (size_t)(BK * 2);
    const size_t hstep = (size_t)HALF * K * 2;
    const size_t tstep = 2 * hstep;
    const unsigned ldsw = (unsigned)wid * 1024u;
    const int aoff = lds_byte(wr * 64 + fr, fq * 8), boff = lds_byte(wc * 32 + fr, fq * 8);
#define PG8_SA(b, h) (((b) * 2 + (h)) * HTB)
#define PG8_SB(b, h) ((4 + (b) * 2 + (h)) * HTB)
#define PG8_STAGE(bufoff, gbase, voff) do { _Pragma("unroll") for (int _i = 0; _i < 2; ++_i) \
        __builtin_amdgcn_global_load_lds((const unsigned*)((const char*)(gbase) + (voff)[_i]), (PG8_LAS unsigned*)(lds + (bufoff) + ldsw + _i * 8192), 16, 0, 0); } while (0)
#define PG8_LDA(dst, b, h) do { _Pragma("unroll") for (int m = 0; m < 4; ++m) _Pragma("unroll") for (int k = 0; k < 2; ++k) dst[m][k] = *(const PG8_LAS bf16x8*)(lds + PG8_SA(b, h) + aoff + m * 2048 + k * 1024); } while (0)
#define PG8_LDB(dst, b, h) do { _Pragma("unroll") for (int n = 0; n < 2; ++n) _Pragma("unroll") for (int k = 0; k < 2; ++k) dst[n][k] = *(const PG8_LAS bf16x8*)(lds + PG8_SB(b, h) + boff + n * 2048 + k * 1024); } while (0)
#define PG8_MMA(ai, bj, At, Bt) do { __builtin_amdgcn_s_setprio(1); _Pragma("unroll") for (int m = 0; m < 4; ++m) _Pragma("unroll") for (int n = 0; n < 2; ++n) _Pragma("unroll") for (int k = 0; k < 2; ++k) \
        acc[ai][bj][m][n] = __builtin_amdgcn_mfma_f32_16x16x32_bf16(Bt[n][k], At[m][k], acc[ai][bj][m][n], 0, 0, 0); __builtin_amdgcn_s_setprio(0); } while (0)
#define PG8_WAIT_V(n) asm volatile("s_waitcnt vmcnt(" #n ")" ::: "memory")
#define PG8_WAIT_L(n) asm volatile("s_waitcnt lgkmcnt(" #n ")" ::: "memory")
#define PG8_BAR __builtin_amdgcn_s_barrier()
#define PG8_SCHED __builtin_amdgcn_sched_barrier(0)
    Unit cur, nxt; int ui = 0;
    if (!S.next(0, cur)) return;
    f32x4 acc[2][2][4][2];
#pragma unroll
    for (int a = 0; a < 2; ++a)
#pragma unroll
        for (int b = 0; b < 2; ++b)
#pragma unroll
            for (int m = 0; m < 4; ++m)
#pragma unroll
                for (int n = 0; n < 2; ++n) acc[a][b][m][n] = (f32x4){0.f, 0.f, 0.f, 0.f};
    bf16x8 At[4][2], B0[2][2], B1[2][2];
    const char* cA = (const char*)g.A + (size_t)cur.pm * tstep + (size_t)cur.kt0 * kstep; const char* cB = (const char*)g.Bt + (size_t)cur.pn * tstep + (size_t)cur.kt0 * kstep;
    S.a_ready(cur);
    if constexpr (SP2) {
        PG8_STAGE(PG8_SB(0, 0), cB, voffB); PG8_STAGE(PG8_SB(0, 1), cB + hstep, voffB); PG8_STAGE(PG8_SA(0, 0), cA, voffA); PG8_STAGE(PG8_SA(0, 1), cA + hstep, voffA);
        if (wr == 1) PG8_BAR;
        PG8_WAIT_V(2); PG8_BAR;
        PG8_STAGE(PG8_SB(1, 0), cB + kstep, voffB); PG8_STAGE(PG8_SA(1, 0), cA + kstep, voffA); PG8_STAGE(PG8_SB(1, 1), cB + hstep + kstep, voffB);
        PG8_WAIT_V(6); PG8_BAR;
    } else {
        PG8_STAGE(PG8_SB(0, 0), cB, voffB); PG8_STAGE(PG8_SA(0, 0), cA, voffA); PG8_STAGE(PG8_SB(0, 1), cB + hstep, voffB); PG8_STAGE(PG8_SA(0, 1), cA + hstep, voffA);
        if (wr == 1) PG8_BAR;
        PG8_WAIT_V(4); PG8_BAR;
        PG8_STAGE(PG8_SB(1, 0), cB + kstep, voffB); PG8_STAGE(PG8_SA(1, 0), cA + kstep, voffA); PG8_STAGE(PG8_SB(1, 1), cB + hstep + kstep, voffB);
        PG8_WAIT_V(6); PG8_BAR;
    }
    for (;;) {
        const bool has_next = S.next(ui + 1, nxt);
        const char* nA = has_next ? (const char*)g.A + (size_t)nxt.pm * tstep + (size_t)nxt.kt0 * kstep : cA; const char* nB = has_next ? (const char*)g.Bt + (size_t)nxt.pn * tstep + (size_t)nxt.kt0 * kstep : cB;
        const int ntu = cur.nt ? cur.nt : nt;
        for (int t = 0; t < ntu; t += 2) {
            const bool last = (t == ntu - 2);
            const char* a1 = cA + (size_t)(t + 1) * kstep;
            const char* a2 = last ? nA : cA + (size_t)(t + 2) * kstep; const char* b2 = last ? nB : cB + (size_t)(t + 2) * kstep;
            const char* a3 = a2 + kstep; const char* b3 = b2 + kstep;
            if (last && has_next) S.a_ready(nxt);
            if constexpr (SP2) {
            PG8_LDB(B0, 0, 0); PG8_LDB(B1, 0, 1); PG8_SCHED; PG8_LDA(At, 0, 0); PG8_STAGE(PG8_SA(1, 1), a1 + hstep, voffA);
            PG8_WAIT_V(8); PG8_WAIT_L(0); PG8_BAR; PG8_MMA(0, 0, At, B0); PG8_MMA(0, 1, At, B1); PG8_BAR; PG8_SCHED;
            PG8_LDA(At, 0, 1); PG8_STAGE(PG8_SB(0, 0), b2, voffB); PG8_STAGE(PG8_SB(0, 1), b2 + hstep, voffB); PG8_STAGE(PG8_SA(0, 0), a2, voffA);
            PG8_WAIT_V(8); PG8_WAIT_L(0); PG8_BAR; PG8_MMA(1, 0, At, B0); PG8_MMA(1, 1, At, B1); PG8_BAR; PG8_SCHED;
            PG8_LDB(B0, 1, 0); PG8_LDB(B1, 1, 1); PG8_SCHED; PG8_LDA(At, 1, 0); PG8_STAGE(PG8_SA(0, 1), a2 + hstep, voffA);
            PG8_WAIT_V(8); PG8_WAIT_L(0); PG8_BAR; PG8_MMA(0, 0, At, B0); PG8_MMA(0, 1, At, B1); PG8_BAR; PG8_SCHED;
            PG8_LDA(At, 1, 1); PG8_STAGE(PG8_SB(1, 0), b3, voffB); PG8_STAGE(PG8_SB(1, 1), b3 + hstep, voffB); PG8_STAGE(PG8_SA(1, 0), a3, voffA);
            PG8_WAIT_V(8); PG8_WAIT_L(0); PG8_BAR; PG8_MMA(1, 0, At, B0); PG8_MMA(1, 1, At, B1); PG8_BAR; PG8_SCHED;
            } else {
            PG8_LDB(B0, 0, 0); PG8_SCHED; PG8_LDA(At, 0, 0); PG8_STAGE(PG8_SA(1, 1), a1 + hstep, voffA);
            PG8_WAIT_L(8); PG8_BAR; PG8_WAIT_L(0); PG8_MMA(0, 0, At, B0); PG8_BAR; PG8_SCHED;
            PG8_LDB(B1, 0, 1); PG8_STAGE(PG8_SB(0, 0), b2, voffB);
            PG8_BAR; PG8_WAIT_L(0); PG8_MMA(0, 1, At, B1); PG8_BAR;
            PG8_LDA(At, 0, 1); PG8_STAGE(PG8_SA(0, 0), a2, voffA);
            PG8_BAR; PG8_WAIT_L(0); PG8_MMA(1, 0, At, B0); PG8_BAR; PG8_SCHED;
            PG8_STAGE(PG8_SB(0, 1), b2 + hstep, voffB);
            PG8_WAIT_V(6); PG8_BAR; PG8_MMA(1, 1, At, B1); PG8_BAR;
            PG8_LDB(B0, 1, 0); PG8_SCHED; PG8_LDA(At, 1, 0); PG8_STAGE(PG8_SA(0, 1), a2 + hstep, voffA);
            PG8_WAIT_L(8); PG8_BAR; PG8_WAIT_L(0); PG8_MMA(0, 0, At, B0); PG8_BAR; PG8_SCHED;
            PG8_LDB(B1, 1, 1); PG8_STAGE(PG8_SB(1, 0), b3, voffB);
            PG8_BAR; PG8_WAIT_L(0); PG8_MMA(0, 1, At, B1); PG8_BAR;
            PG8_LDA(At, 1, 1); PG8_STAGE(PG8_SA(1, 0), a3, voffA);
            PG8_BAR; PG8_WAIT_L(0); PG8_MMA(1, 0, At, B0); PG8_BAR; PG8_SCHED;
            PG8_STAGE(PG8_SB(1, 1), b3 + hstep, voffB);
            PG8_WAIT_V(6); PG8_BAR; PG8_MMA(1, 1, At, B1); PG8_BAR;
            }
        }
        if constexpr (ALIGN_EPI) { if (wr == 0) PG8_BAR; }
        if constexpr (!Epi::AFTER_DRAIN) { E(acc, cur, wr, wc, fr, fq); S.done(cur); }
        if (!has_next) break;
#pragma unroll
        for (int a = 0; a < 2; ++a)
#pragma unroll
            for (int b = 0; b < 2; ++b)
#pragma unroll
                for (int m = 0; m < 4; ++m)
#pragma unroll
                    for (int n = 0; n < 2; ++n) acc[a][b][m][n] = (f32x4){0.f, 0.f, 0.f, 0.f};
        cur = nxt; cA = nA; cB = nB; ++ui;
        if constexpr (ALIGN_EPI) { if (wr == 1) PG8_BAR; }
    }
    PG8_WAIT_V(0);
    if constexpr (!ALIGN_EPI) { if (wr == 0) PG8_BAR; }
    PG8_BAR;
    if constexpr (Epi::AFTER_DRAIN) { E.fused(acc, cur, wr, wc, fr, fq, lds, wid, lane); S.done(cur); }
#undef PG8_SA
#undef PG8_SB
#undef PG8_STAGE
#undef PG8_LDA
#undef PG8_LDB
#undef PG8_MMA
#undef PG8_WAIT_V
#undef PG8_WAIT_L
#undef PG8_BAR
#undef PG8_SCHED
}
}

#ifndef PG8_SP2
#define PG8_SP2 true
#endif
#ifndef PG8_ALIGN
#define PG8_ALIGN true
#endif
constexpr int RING_OFF = 0, RING_BYTES = 131072;
constexpr int LDSCTL_OFF = RING_BYTES, MISC_OFF = LDSCTL_OFF + 320;
constexpr int LDS_BYTES = 147456;

typedef GAS unsigned gu32;
#define RLX_AGENT __ATOMIC_RELAXED, __HIP_MEMORY_SCOPE_AGENT
#define LDS_WAIT() asm volatile("s_waitcnt lgkmcnt(0)" ::: "memory")
#define VM_WAIT() asm volatile("s_waitcnt vmcnt(0)" ::: "memory")
constexpr int CW_BAR = 4096;
#define XB_TMO      128
#define XB_XCNT(j)  (256  + 64 * (j))
#define XB_XSUB(j)  (1280 + 64 * (j))
#define XB_XGEN(j)  (2304 + 64 * (j))
#define XB_TOP      3328
#define XB_TOPGEN   3392
#define XCD_BAR_WORDS 3456
#define XB_SPIN_CAP (1u << 18)

__device__ __forceinline__ unsigned xb_ld(unsigned* p)              { return __hip_atomic_load(p, __ATOMIC_RELAXED, __HIP_MEMORY_SCOPE_AGENT); }
__device__ __forceinline__ unsigned xb_add(unsigned* p, unsigned v) { return __hip_atomic_fetch_add(p, v, __ATOMIC_RELAXED, __HIP_MEMORY_SCOPE_AGENT); }
__device__ __forceinline__ unsigned xb_xcc_id() { return (unsigned)__builtin_amdgcn_s_getreg((3 << 11) | 20) & 0xFu; }
#define XB_SPIN(cond, bar) do { unsigned _sp = 0; while (cond) { __builtin_amdgcn_s_sleep(1); \
    if ((++_sp & 255u) == 0u) { if (xb_ld(&(bar)[XB_TMO])) break; if (_sp > XB_SPIN_CAP) { atomicAdd(&(bar)[XB_TMO], 1u); break; } } } } while (0)

struct XcdBarrier {
    unsigned* bar; unsigned x;
    volatile LAS unsigned* st;
};

__device__ __forceinline__ XcdBarrier xcd_barrier_post(unsigned* bar, volatile LAS unsigned* st) {
    XcdBarrier b; b.bar = bar; b.x = xb_xcc_id(); b.st = st;
    if (threadIdx.x == 0) (void)xb_add(&bar[XB_XCNT(b.x)], 1u);
    return b;
}
__device__ __forceinline__ void xcd_barrier_complete(unsigned* bar, unsigned x, unsigned& nloc, unsigned& nx) {
    const unsigned G = gridDim.x * gridDim.y * gridDim.z;
    unsigned sum, cnt, mine, sp = 0u;
    for (;;) {
        sum = 0u; cnt = 0u; mine = 0u;
#pragma unroll
        for (unsigned j = 0; j < 16; ++j) { const unsigned c = xb_ld(&bar[XB_XCNT(j)]); sum += c; cnt += (c > 0u) ? 1u : 0u; mine = (j == x) ? c : mine; }
        if (sum == G) break;
        __builtin_amdgcn_s_sleep(1);
        if ((++sp & 255u) == 0u) { if (xb_ld(&bar[XB_TMO])) break; if (sp > XB_SPIN_CAP) { atomicAdd(&bar[XB_TMO], 1u); break; } }
    }
    nloc = mine > 0u ? mine : 1u; nx = cnt > 0u ? cnt : 1u;
}

__device__ __forceinline__ void xcd_barrier(const XcdBarrier& b) {
    asm volatile("s_waitcnt vmcnt(0)" ::: "memory");
    __syncthreads();
    if (threadIdx.x == 0) {
        unsigned* bar = b.bar;
        __builtin_amdgcn_s_waitcnt(0);
        unsigned nloc = b.st[0], nx = b.st[1];
        if (nloc == 0u) { xcd_barrier_complete(bar, b.x, nloc, nx); b.st[0] = nloc; b.st[1] = nx; }
        const unsigned old = xb_add(&bar[XB_XSUB(b.x)], 1u);
        const unsigned gen = old / nloc;
        if (old + 1u == (gen + 1u) * nloc) {
            __builtin_amdgcn_fence(__ATOMIC_RELEASE, "agent");
            asm volatile("s_waitcnt vmcnt(0)" ::: "memory");
            const unsigned og = xb_add(&bar[XB_TOP], 1u);
            const unsigned tg = og / nx;
            if (og + 1u == (tg + 1u) * nx) xb_add(&bar[XB_TOPGEN], 1u);
            else XB_SPIN(xb_ld(&bar[XB_TOPGEN]) == tg, bar);
            __builtin_amdgcn_fence(__ATOMIC_ACQUIRE, "agent");
            xb_add(&bar[XB_XGEN(b.x)], 1u);
            asm volatile("s_waitcnt vmcnt(0)" ::: "memory");
        } else {
            XB_SPIN(xb_ld(&bar[XB_XGEN(b.x)]) == gen, bar);
            __builtin_amdgcn_fence(__ATOMIC_ACQUIRE, "agent");
            asm volatile("s_waitcnt vmcnt(0)" ::: "memory");
        }
    }
    __syncthreads();
}

typedef __attribute__((address_space(4))) const unsigned long long* kargp_t;
struct Frame {
    LAS unsigned char* lds;
    int tid, lane, wave, G, gw, ngw;
    unsigned char* ws;
    kargp_t kp; int cu;
};
__device__ __forceinline__ kargp_t kargs() {
    const unsigned long long v = (unsigned long long)__builtin_amdgcn_kernarg_segment_ptr(); unsigned lo = (unsigned)v, hi = (unsigned)(v >> 32);
    asm volatile("" : "+s"(lo), "+s"(hi)); return (kargp_t)(((unsigned long long)hi << 32) | lo);
}
__device__ __forceinline__ void relaunder(Frame& F) {
    int t = threadIdx.x; asm volatile("" : "+v"(t));
    int bx = __builtin_amdgcn_readfirstlane((int)blockIdx.x); asm volatile("" : "+s"(bx));
    F.kp = kargs(); F.ws = (unsigned char*)(GAS unsigned char*)F.kp[26]; F.cu = bx;
    F.tid = t; F.lane = t & 63; F.wave = __builtin_amdgcn_readfirstlane(t >> 6); F.gw = bx * NWAVES + F.wave;
}
__device__ __forceinline__ float wave_sum(float v) {
#pragma unroll
    for (int o = 1; o < 64; o <<= 1) v += __shfl_xor(v, o);
    return v;
}
__device__ __forceinline__ float bf2f(unsigned short x) { return __uint_as_float((unsigned)x << 16); }
__device__ __forceinline__ float bflo(unsigned x) { return __uint_as_float(x << 16); }
__device__ __forceinline__ float bfhi(unsigned x) { return __uint_as_float(x & 0xffff0000u); }
using pg8::cvt_pk_bf16;
using pg8::sigmoid_fast;

enum { I_X = 0, I_C, I_CTX, I_CCTX, I_MODW, I_MODB, I_LNMG, I_LNMB, I_LNFG, I_LNFB, I_WG, I_WU, I_WDN, I_WIN, I_CONVW, I_CONVB, I_GAW, I_GAB, I_GXW, I_GXB, I_LAM, I_WOUT, I_WQKV, I_SINK, I_WO };

__device__ __forceinline__ void p0_transpose_item(const float* W, int K, int N, bf16_t* WT, int k0, int n0, int drow0, LAS float* scr, int lane) {
#pragma unroll 8
    for (int i = 0; i < 32; ++i) { const int kk = 2 * i + (lane >> 5); scr[kk * 33 + (lane & 31)] = W[(size_t)(k0 + kk) * N + n0 + (lane & 31)]; }
    LDS_WAIT(); asm volatile("" ::: "memory");
    const int c = lane & 7;
#pragma unroll
    for (int j = 0; j < 4; ++j) { const int n = (lane >> 3) + 8 * j; const LAS float* s = scr + (8 * c) * 33 + n;
        u32x4 o; o.x = cvt_pk_bf16(s[0 * 33], s[1 * 33]); o.y = cvt_pk_bf16(s[2 * 33], s[3 * 33]); o.z = cvt_pk_bf16(s[4 * 33], s[5 * 33]); o.w = cvt_pk_bf16(s[6 * 33], s[7 * 33]);
        *(GAS u32x4*)(WT + (size_t)(drow0 + n) * K + k0 + 8 * c) = o; }
    LDS_WAIT(); asm volatile("" ::: "memory");
}
__device__ __forceinline__ float silu_acc(float x) { return x / (1.f + expf(-x)); }
constexpr int CV_IT_FFN = (D / 64) * (FF / 32), CV_IT_WIN = CV_IT_FFN, CV_IT_WOUT = (DR / 64) * (D / 32), CV_IT_QKV = (D / 64) * (NQKV / 32), CV_IT_WO = (D / 64) * (D / 32);
constexpr int CV_N_FFN = DEPTH * 3 * CV_IT_FFN, CV_N_REC = 2 * (CV_IT_WIN + CV_IT_WOUT), CV_N_ATT = 2 * (CV_IT_QKV + CV_IT_WO), CV_NITEMS = CV_N_FFN + CV_N_REC + CV_N_ATT;
struct CvDesc { const float* W; bf16_t* WT; int K, N, nblk, map; };
__device__ __forceinline__ int cv_drow(int map, int n0) {
    if (map == 1) return (n0 >> 7) * 256 + (n0 & 127);
    if (map == 2) return (n0 >> 7) * 256 + 128 + (n0 & 127);
    if (map == 3 && n0 < NQK) { const int pn = n0 >> 8, rem = n0 & 255, hd = rem >> 7, d = rem & 127; return pn * 256 + (d >> 6) * 128 + hd * 64 + (d & 63); }
    return n0;
}
__device__ __forceinline__ void cv_matrix(Frame& F, int it, CvDesc& d, int& q) {
    int r = it;
    if (r < CV_N_FFN) { const int L = r / (3 * CV_IT_FFN), w = (r / CV_IT_FFN) % 3; q = r % CV_IT_FFN;
        if (w < 2) { d.W = ((const float*)(GAS const float*)F.kp[w == 0 ? I_WG : I_WU]) + (size_t)L * D * FF; d.WT = (bf16_t*)(F.ws + WS_WGU) + (size_t)L * (2 * FF) * D; d.K = D; d.N = FF; d.nblk = FF / 32; d.map = 1 + w; }
        else { d.W = ((const float*)(GAS const float*)F.kp[I_WDN]) + (size_t)L * FF * D; d.WT = (bf16_t*)(F.ws + WS_WD) + (size_t)L * D * FF; d.K = FF; d.N = D; d.nblk = D / 32; d.map = 0; }
        return; }
    r -= CV_N_FFN;
    if (r < CV_N_REC) { const int j = r / (CV_IT_WIN + CV_IT_WOUT); q = r % (CV_IT_WIN + CV_IT_WOUT);
        if (q < CV_IT_WIN) { d.W = ((const float*)(GAS const float*)F.kp[I_WIN]) + (size_t)j * D * FF; d.WT = (bf16_t*)(F.ws + WS_WIN) + (size_t)j * FF * D; d.K = D; d.N = FF; d.nblk = FF / 32; d.map = 0; }
        else { q -= CV_IT_WIN; d.W = ((const float*)(GAS const float*)F.kp[I_WOUT]) + (size_t)j * DR * D; d.WT = (bf16_t*)(F.ws + WS_WOUT) + (size_t)j * D * DR; d.K = DR; d.N = D; d.nblk = D / 32; d.map = 0; }
        return; }
    r -= CV_N_REC;
    { const int j = r / (CV_IT_QKV + CV_IT_WO); q = r % (CV_IT_QKV + CV_IT_WO);
        if (q < CV_IT_QKV) { d.W = ((const float*)(GAS const float*)F.kp[I_WQKV]) + (size_t)j * D * NQKV; d.WT = (bf16_t*)(F.ws + WS_WQKV) + (size_t)j * NQKV * D; d.K = D; d.N = NQKV; d.nblk = NQKV / 32; d.map = 3; }
        else { q -= CV_IT_QKV; d.W = ((const float*)(GAS const float*)F.kp[I_WO]) + (size_t)j * D * D; d.WT = (bf16_t*)(F.ws + WS_WO) + (size_t)j * D * D; d.K = D; d.N = D; d.nblk = D / 32; d.map = 0; } }
}


__device__ __forceinline__ void phase_p0a(Frame& F) {
    relaunder(F);
    const int bx = F.cu;
    if (bx < DEPTH * (MODN / 256)) {
        const int L = bx / (MODN / 256), nb = bx % (MODN / 256);
        LAS float* sl = (LAS float*)(F.lds);
        LAS float* red = (LAS float*)(F.lds + 5 * D * 4);
        const float* c = ((const float*)(GAS const float*)F.kp[I_C]); const float* cc = ((const float*)(GAS const float*)F.kp[I_CCTX]);
        for (int i = F.tid; i < 5 * D; i += NWAVES * 64) { const int r = i / D, k = i % D; sl[i] = silu_acc(r < 4 ? c[r * D + k] : cc[k]); }
        __syncthreads();
        const float* W = ((const float*)(GAS const float*)F.kp[I_MODW]) + ((size_t)L * D + F.wave * 256) * MODN + nb * 256 + F.lane * 4;
        f32x4 a0 = {0.f, 0.f, 0.f, 0.f}, a1 = a0, a2 = a0, a3 = a0, a4 = a0;
        const LAS float* s0 = sl + F.wave * 256;
#pragma unroll 8
        for (int k = 0; k < 256; ++k) { const f32x4 w = *(const f32x4*)(W + (size_t)k * MODN);
            a0 += w * s0[k]; a1 += w * s0[D + k]; a2 += w * s0[2 * D + k]; a3 += w * s0[3 * D + k]; a4 += w * s0[4 * D + k]; }
        LAS f32x4* rw = (LAS f32x4*)(red + F.wave * 5 * 256) + F.lane;
        rw[0] = a0; rw[64] = a1; rw[128] = a2; rw[192] = a3; rw[256] = a4;
        __syncthreads();
        float* modv = (float*)(F.ws + WS_MODV);
        for (int o = F.tid; o < 5 * 256; o += NWAVES * 64) { const int r = o >> 8, n = o & 255; float s = 0.f;
#pragma unroll
            for (int w = 0; w < 8; ++w) s += red[w * 5 * 256 + r * 256 + n];
            modv[((size_t)L * 5 + r) * MODN + nb * 256 + n] = s + ((const float*)(GAS const float*)F.kp[I_MODB])[(size_t)L * MODN + nb * 256 + n]; }
        __syncthreads();
    } else if (bx == 255) {
        f32x2* tab = (f32x2*)(F.ws + WS_ROPE);
        for (int i = F.tid; i < 64 * 32; i += NWAVES * 64) { const int pos = i >> 5, f = i & 31; const float inv = powf(10000.f, -(float)(2 * f) / 64.f); const float ang = (float)pos * inv;
            tab[i] = (f32x2){cosf(ang), sinf(ang)}; }
    }
    LAS float* scr = (LAS float*)(F.lds + F.wave * 8448);
    for (int it = CV_N_FFN + F.gw; it < CV_N_FFN + CV_IT_WIN; it += F.ngw) {
        CvDesc d; int q; cv_matrix(F, it, d, q);
        const int kb = q / d.nblk, nb = q % d.nblk;
        p0_transpose_item(d.W, d.K, d.N, d.WT, kb * 64, nb * 32, cv_drow(d.map, nb * 32), scr, F.lane);
    }
}

template <int MODE>
__device__ __forceinline__ void phase_rows(Frame& F, int nrows, const float* gam, const float* bet, const float* modS, int off_sh, int off_sc, const float* slab = nullptr, const float* gslab = nullptr) {
    relaunder(F);
    float* HA = (float*)(F.ws + WS_HA); bf16_t* U = (bf16_t*)(F.ws + WS_U);
    for (int row = F.gw; row < nrows; row += F.ngw) {
        const int r = row < ML ? (row >> 12) : 4;
        f32x4 v[8];
        if (MODE == 0) { const float* src = row < ML ? ((const float*)(GAS const float*)F.kp[I_X]) + (size_t)row * D : ((const float*)(GAS const float*)F.kp[I_CTX]) + (size_t)(row - ML) * D;
#pragma unroll
            for (int j = 0; j < 8; ++j) v[j] = *(const f32x4*)(src + 4 * F.lane + 256 * j);
        } else {
            float s = 0.f;
#pragma unroll
            for (int j = 0; j < 8; ++j) v[j] = *(const f32x4*)(HA + (size_t)row * D + 4 * F.lane + 256 * j);
            if (slab != nullptr && row >= ML) {
#pragma unroll
                for (int j = 0; j < 8; ++j) { const int c = 4 * F.lane + 256 * j; f32x4 ps = {0.f, 0.f, 0.f, 0.f};
#pragma unroll
                    for (int q = 0; q < 8; ++q) ps += *(const f32x4*)(slab + ((size_t)q * MC + (row - ML)) * D + c);
                    v[j] += *(const f32x4*)(gslab + c) * ps; } }
#pragma unroll
            for (int j = 0; j < 8; ++j) s += (v[j][0] + v[j][1]) + (v[j][2] + v[j][3]);
            const float mean = wave_sum(s) * (1.f / D); float q = 0.f;
#pragma unroll
            for (int j = 0; j < 8; ++j) { v[j] = v[j] - mean; q += (v[j][0] * v[j][0] + v[j][1] * v[j][1]) + (v[j][2] * v[j][2] + v[j][3] * v[j][3]); }
            const float rstd = 1.f / sqrtf(wave_sum(q) * (1.f / D) + LN_EPS);
            if (MODE == 1 && F.lane == 0) *(f32x2*)((float*)(F.ws + WS_STATS) + 2 * (size_t)row) = (f32x2){mean, rstd};
#pragma unroll
            for (int j = 0; j < 8; ++j) { const f32x4 g = *(const f32x4*)(gam + 4 * F.lane + 256 * j), b = *(const f32x4*)(bet + 4 * F.lane + 256 * j); v[j] = v[j] * rstd * g + b; }
        }
        if (MODE == 2) {
#pragma unroll
            for (int j = 0; j < 8; ++j) *(f32x4*)(((float*)(GAS float*)F.kp[25]) + (size_t)row * D + 4 * F.lane + 256 * j) = v[j];
        } else {
            const float* ms = modS + (size_t)r * MODN;
#pragma unroll
            for (int j = 0; j < 8; ++j) { const int c = 4 * F.lane + 256 * j;
                if (row >= ML) *(f32x4*)(HA + (size_t)row * D + c) = v[j] * ALPHA;
                const f32x4 sc = *(const f32x4*)(ms + off_sc + c), sh = *(const f32x4*)(ms + off_sh + c); const f32x4 u = v[j] * (sc + 1.0f) + sh;
                u32x2 w; w.x = cvt_pk_bf16(u[0], u[1]); w.y = cvt_pk_bf16(u[2], u[3]); *(u32x2*)(U + (size_t)row * D + c) = w; }
        }
    }
}

__device__ __forceinline__ void phase_conv(Frame& F, int j) {
    relaunder(F);
    const bf16_t* P = (const bf16_t*)(F.ws + WS_BIG); bf16_t* Z = (bf16_t*)(F.ws + WS_Z);
    const float* cw = ((const float*)(GAS const float*)F.kp[I_CONVW]) + (size_t)j * 4 * DR; const float* cb = ((const float*)(GAS const float*)F.kp[I_CONVB]) + (size_t)j * DR;
    constexpr int RCH = 16, NITEMS = (MT / RCH) * 6;
    for (int it = F.gw; it < NITEMS; it += F.ngw) {
        const int rc = it / 6, cbk = it % 6, row0 = rc * RCH;
        const int pc0 = cbk * 512 + F.lane * 8, hb = pc0 / 192, i0 = pc0 % 192; const bool valid = i0 < BW; const int ch = hb * BW + i0;
        const int seq_lo = row0 < ML ? (row0 & ~(SEQ - 1)) : (ML + ((row0 - ML) & ~(CTXL - 1))), seq_hi = seq_lo + (row0 < ML ? SEQ : CTXL);
        const int chc = valid ? ch : hb * BW;
        float w[4][8], bias[8];
        { const f32x4 b0 = *(const f32x4*)(cb + chc), b1 = *(const f32x4*)(cb + chc + 4);
#pragma unroll
          for (int e = 0; e < 4; ++e) { bias[e] = valid ? b0[e] : 0.f; bias[4 + e] = valid ? b1[e] : 0.f; }
#pragma unroll
          for (int t = 0; t < 4; ++t) { const f32x4 w0 = *(const f32x4*)(cw + t * DR + chc), w1 = *(const f32x4*)(cw + t * DR + chc + 4);
#pragma unroll
              for (int e = 0; e < 4; ++e) { w[t][e] = valid ? w0[e] : 0.f; w[t][4 + e] = valid ? w1[e] : 0.f; } } }
        const bf16_t* src = P + DR + chc;
#define ld(rw) ([&]() -> u32x4 { const int rw_ = (rw); const int rc_ = rw_ < seq_lo ? seq_lo : (rw_ >= seq_hi ? seq_hi - 1 : rw_); u32x4 z_ = *(const u32x4*)(src + (size_t)rc_ * FF); \
        const bool in_ = rw_ >= seq_lo && rw_ < seq_hi; z_.x = in_ ? z_.x : 0u; z_.y = in_ ? z_.y : 0u; z_.z = in_ ? z_.z : 0u; z_.w = in_ ? z_.w : 0u; return z_; }())
        u32x4 xr[RCH + 3];
#pragma unroll
        for (int i = 0; i < RCH + 3; ++i) xr[i] = ld(row0 - 2 + i);
#pragma unroll
        for (int i = 0; i < RCH; ++i) {
            const int row = row0 + i; const u32x4 xm2 = xr[i], xm1 = xr[i + 1], x0 = xr[i + 2], xp1 = xr[i + 3];
            float o[8];
#pragma unroll
            for (int e = 0; e < 8; ++e) { const int wd = e >> 1; const bool hi = e & 1;
                const float a = hi ? bfhi(xm2[wd]) : bflo(xm2[wd]), b = hi ? bfhi(xm1[wd]) : bflo(xm1[wd]), c = hi ? bfhi(x0[wd]) : bflo(x0[wd]), d = hi ? bfhi(xp1[wd]) : bflo(xp1[wd]);
                o[e] = bias[e] + w[0][e] * a + w[1][e] * b + w[2][e] * c + w[3][e] * d; }
            u32x4 ov; ov.x = cvt_pk_bf16(o[0], o[1]); ov.y = cvt_pk_bf16(o[2], o[3]); ov.z = cvt_pk_bf16(o[4], o[5]); ov.w = cvt_pk_bf16(o[6], o[7]);
            {
                const int bb = row < ML ? (row >> 12) : ((row - ML) >> 8), tl = row < ML ? (16 + ((row & (SEQ - 1)) >> 4)) : (((row - ML) & (CTXL - 1)) >> 4);
                const size_t zo = ((((size_t)(bb * 16 + hb) * 272 + tl) * 6 + (i0 >> 5)) * 64 + ((i0 & 31) >> 3) * 16 + (row & 15)) * 8;
                *(u32x4*)(Z + zo) = ov; }
        }
#undef ld
    }
}

template <int CTRL> __device__ __forceinline__ float dpp_f(float old, float v) {
    return __builtin_bit_cast(float, __builtin_amdgcn_update_dpp(__builtin_bit_cast(int, old), __builtin_bit_cast(int, v), CTRL, 0xf, 0xf, false));
}
template <int REV> __device__ __forceinline__ void row_scan(float& P, float& H) {
#define RS_STEP(C) { const float hs = dpp_f<C>(0.f, H), ps = dpp_f<C>(1.f, P); H = fmaf(P, hs, H); P = P * ps; }
    if (REV == 0) { RS_STEP(0x111) RS_STEP(0x112) RS_STEP(0x114) RS_STEP(0x118) }
    else          { RS_STEP(0x101) RS_STEP(0x102) RS_STEP(0x104) RS_STEP(0x108) }
#undef RS_STEP
}
template <int REV> __device__ __forceinline__ void row_scan4(f32x4& P, f32x4& H) {
    float p0 = P[0], p1 = P[1], p2 = P[2], p3 = P[3], h0 = H[0], h1 = H[1], h2 = H[2], h3 = H[3];
#define RS4(SH) asm volatile("s_nop 1\n\t" \
        "v_fmac_f32_dpp %0, %0, %4 " SH " row_mask:0xf bank_mask:0xf\n\tv_fmac_f32_dpp %1, %1, %5 " SH " row_mask:0xf bank_mask:0xf\n\t" \
        "v_fmac_f32_dpp %2, %2, %6 " SH " row_mask:0xf bank_mask:0xf\n\tv_fmac_f32_dpp %3, %3, %7 " SH " row_mask:0xf bank_mask:0xf\n\t" \
        "v_mul_f32_dpp %4, %4, %4 " SH " row_mask:0xf bank_mask:0xf\n\tv_mul_f32_dpp %5, %5, %5 " SH " row_mask:0xf bank_mask:0xf\n\t" \
        "v_mul_f32_dpp %6, %6, %6 " SH " row_mask:0xf bank_mask:0xf\n\tv_mul_f32_dpp %7, %7, %7 " SH " row_mask:0xf bank_mask:0xf" \
        : "+v"(h0), "+v"(h1), "+v"(h2), "+v"(h3), "+v"(p0), "+v"(p1), "+v"(p2), "+v"(p3))
    if (REV == 0) { RS4("row_shr:1"); RS4("row_shr:2"); RS4("row_shr:4"); RS4("row_shr:8"); }
    else          { RS4("row_shl:1"); RS4("row_shl:2"); RS4("row_shl:4"); RS4("row_shl:8"); }
#undef RS4
    P = (f32x4){p0, p1, p2, p3}; H = (f32x4){h0, h1, h2, h3};
}
typedef int i32x4 __attribute__((ext_vector_type(4)));
constexpr int RS_NS = 8, RS_PD = 5, RS_TILE_B = 6144, RS_RING = RS_NS * RS_TILE_B, RS_HS = 4, RS_HD = 3;
template <int DIR, bool ACTIVE>
__device__ __forceinline__ void rec_sweep(Frame& F, int j, int b, int hb, int ct, int k) {
    const int lane = F.lane, fr = lane & 15, fq = lane >> 4;
    const __amdgpu_buffer_rsrc_t rW = __builtin_amdgcn_make_buffer_rsrc((void*)F.ws, 0, (int)WS_END, 0x00020000);
    const int voH = (fr * 16 + 4 * fq) * 2, voP = (fr * FF + 4 * fq) * 2, voV = (fr * DR + 4 * fq) * 2;
    const int sTrash = (int)(WS_HF + (size_t)MT * DR * 2 + 65536) + F.gw * 2048;
    LAS unsigned char* ring = F.lds + DIR * RS_RING;
    const int zso = (int)WS_Z + (b * 16 + hb) * 272 * RS_TILE_B + (2 * k) * 1024, zlo = lane * 16;
    const size_t wbase = ((size_t)(j * 2 + DIR) * 16 + hb) * BW * BW;
    const float* Wa = ((const float*)(GAS const float*)F.kp[I_GAW]) + wbase; const float* Wx = ((const float*)(GAS const float*)F.kp[I_GXW]) + wbase;
    bf16x8 Af[2][6];
    const int oc = ct * 16 + fr;
#pragma unroll
    for (int ks = 0; ks < 6; ++ks) { float va[8], vx[8];
#pragma unroll
        for (int jj = 0; jj < 8; ++jj) { const int i = ks * 32 + 8 * fq + jj; const bool ok = i < BW; va[jj] = ok ? Wa[(size_t)i * BW + oc] : 0.f; vx[jj] = ok ? Wx[(size_t)i * BW + oc] : 0.f; }
        u32x4 pa, px; pa.x = cvt_pk_bf16(va[0], va[1]); pa.y = cvt_pk_bf16(va[2], va[3]); pa.z = cvt_pk_bf16(va[4], va[5]); pa.w = cvt_pk_bf16(va[6], va[7]);
        px.x = cvt_pk_bf16(vx[0], vx[1]); px.y = cvt_pk_bf16(vx[2], vx[3]); px.z = cvt_pk_bf16(vx[4], vx[5]); px.w = cvt_pk_bf16(vx[6], vx[7]);
        Af[0][ks] = __builtin_bit_cast(bf16x8, pa); Af[1][ks] = __builtin_bit_cast(bf16x8, px); }
    const int cg = hb * BW + ct * 16 + 4 * fq; const size_t pv = (size_t)(j * 2 + DIR) * DR + cg;
    const f32x4 ba = *(const f32x4*)(((const float*)(GAS const float*)F.kp[I_GAB]) + pv) * (-LOG2E), bx = *(const f32x4*)(((const float*)(GAS const float*)F.kp[I_GXB]) + pv) * (-LOG2E), lam = *(const f32x4*)(((const float*)(GAS const float*)F.kp[I_LAM]) + pv);
    f32x4 c1;
#pragma unroll
    for (int e = 0; e < 4; ++e) c1[e] = -8.0f * LOG2E * log1pf(expf(-lam[e]));
    f32x4 hst = {0.f, 0.f, 0.f, 0.f};
    const int hfs = (hb * 11 + ct) * (MT * 16), cgs = hb * BW + ct * 16;
    const int zzo = (ct >> 1) * 1024 + ((2 * (ct & 1) + (fq >> 1)) * 16 + fr) * 16 + (fq & 1) * 8;
#define RS_ROW0(s) (DIR == 0 ? ((s) < 16 ? (ML + b * CTXL + 16 * (s)) : (b * SEQ + 16 * ((s) - 16))) : ((s) < 16 ? (ML + b * CTXL + 16 * (15 - (s))) : (b * SEQ + 16 * (255 - ((s) - 16)))))
#define RS_TL(s) (DIR == 0 ? (s) : ((s) < 16 ? 15 - (s) : 287 - (s)))
#define RS_COMBINE(s) (((s) >= 8 && (s) < 16) || (s) >= 144)
#define RS_DMA(s) do { const int st_ = (s) < 272 ? (s) : 271; const int so_ = zso + RS_TL(st_) * RS_TILE_B; LAS unsigned char* l_ = ring + (st_ & (RS_NS - 1)) * RS_TILE_B + (2 * k) * 1024; \
        __builtin_amdgcn_raw_ptr_buffer_load_lds(rW, (LAS unsigned*)l_, 16, zlo, so_, 0, 0); __builtin_amdgcn_raw_ptr_buffer_load_lds(rW, (LAS unsigned*)(l_ + 1024), 16, zlo, so_ + 1024, 0, 0); } while (0)
    LAS unsigned char* hyr = F.lds + 2 * RS_RING + F.wave * 4096;
    const int voY = ((lane >> 3) * FF) * 2 + (lane & 7) * 4, voH4 = lane * 4;
#define RS_LOADS(s, REAL) do { const int st_ = (s) < 272 ? (s) : 271; const bool cmb_ = (REAL) ? true : ((st_ >= 11 && st_ < 16) || st_ >= 147); \
        const int sy_ = (int)WS_BIG + (RS_ROW0(st_) * FF + cgs) * 2; \
        const int sh_ = cmb_ ? (int)WS_HF + (hfs + RS_ROW0(st_) * 16) * 2 : sy_; const int sh2_ = cmb_ ? 256 : 8 * FF * 2; const int ho_ = cmb_ ? voH4 : voY; \
        LAS unsigned char* l_ = hyr + (st_ & (RS_HS - 1)) * 1024; \
        __builtin_amdgcn_raw_ptr_buffer_load_lds(rW, (LAS unsigned*)l_, 4, ho_, sh_, 0, 0); __builtin_amdgcn_raw_ptr_buffer_load_lds(rW, (LAS unsigned*)(l_ + 256), 4, ho_, sh_ + sh2_, 0, 0); \
        __builtin_amdgcn_raw_ptr_buffer_load_lds(rW, (LAS unsigned*)(l_ + 512), 4, voY, sy_, 0, 0); __builtin_amdgcn_raw_ptr_buffer_load_lds(rW, (LAS unsigned*)(l_ + 768), 4, voY, sy_ + 8 * FF * 2, 0, 0); } while (0)
#define RS_MMA(s, aa_, ax_) do { if (ACTIVE) { const LAS unsigned char* tb_ = ring + ((s) & (RS_NS - 1)) * RS_TILE_B; bf16x8 bfr[6]; \
        _Pragma("unroll") for (int ks = 0; ks < 6; ++ks) bfr[ks] = *(const LAS bf16x8*)(tb_ + ks * 1024 + lane * 16); \
        aa_ = (f32x4){0.f, 0.f, 0.f, 0.f}; ax_ = aa_; \
        _Pragma("unroll") for (int ks = 0; ks < 6; ++ks) { aa_ = __builtin_amdgcn_mfma_f32_16x16x32_bf16(Af[0][ks], bfr[ks], aa_, 0, 0, 0); ax_ = __builtin_amdgcn_mfma_f32_16x16x32_bf16(Af[1][ks], bfr[ks], ax_, 0, 0, 0); } } } while (0)
#define RS_EWA(s, aa_, ax_, P_, H_) do { if (ACTIVE) { const u32x2 zz_ = *(const LAS u32x2*)(ring + ((s) & (RS_NS - 1)) * RS_TILE_B + zzo); \
        const float zv[4] = {bflo(zz_[0]), bfhi(zz_[0]), bflo(zz_[1]), bfhi(zz_[1])}; \
        _Pragma("unroll") for (int e = 0; e < 4; ++e) { \
            const float rg = __builtin_amdgcn_rcpf(1.0f + __builtin_amdgcn_exp2f(fmaf(aa_[e], -LOG2E, ba[e]))), ig = __builtin_amdgcn_rcpf(1.0f + __builtin_amdgcn_exp2f(fmaf(ax_[e], -LOG2E, bx[e])));     \
            P_[e] = __builtin_amdgcn_exp2f(c1[e] * rg); \
            H_[e] = __builtin_amdgcn_sqrtf(fmaf(-P_[e], P_[e], 1.0f)) * ig * zv[e]; } } } while (0)
#define RS_STEP(s, aN_, xN_, aM_, xM_, PM_, HM_, PC_, HC_, FLIPCODE) do {     \
        if ((s) == 8 || (s) == 144) asm volatile("s_waitcnt vmcnt(0)" ::: "memory"); else asm volatile("s_waitcnt vmcnt(16)" ::: "memory"); \
        asm volatile("s_waitcnt lgkmcnt(0)" ::: "memory"); __builtin_amdgcn_s_barrier(); asm volatile("" ::: "memory"); \
        FLIPCODE; \
        RS_DMA((s) + RS_PD); \
        RS_MMA((s) + 2, aN_, xN_); \
        RS_EWA((s) + 1, aM_, xM_, PM_, HM_); \
        if (ACTIVE) { \
        const bool cmb = RS_COMBINE(s); f32x4 aa, hn; \
        const u32x2 hp_ = *(const LAS u32x2*)(hyr + ((s) & (RS_HS - 1)) * 1024 + fr * 32 + fq * 8), yy_ = *(const LAS u32x2*)(hyr + ((s) & (RS_HS - 1)) * 1024 + 512 + fr * 32 + fq * 8); \
        { f32x4 Pv4 = PC_, Hv4 = HC_; \
          row_scan4<DIR>(Pv4, Hv4); \
          _Pragma("unroll") for (int e = 0; e < 4; ++e) { \
            const float Hv = fmaf(Pv4[e], hst[e], Hv4[e]); \
            hn[e] = __shfl(Hv, (lane & 48) | (DIR == 0 ? 15 : 0)); \
            aa[e] = Hv; } } \
        hst = hn; \
        { u32x2 hw_; hw_.x = cvt_pk_bf16(aa[0], aa[1]); hw_.y = cvt_pk_bf16(aa[2], aa[3]); __builtin_amdgcn_raw_buffer_store_b64(hw_, rW, voH, cmb ? sTrash : (int)WS_HF + (hfs + RS_ROW0(s) * 16) * 2, 0); } \
        { const float yv[4] = {bflo(yy_[0]), bfhi(yy_[0]), bflo(yy_[1]), bfhi(yy_[1])}; \
            u32x2 o; o.x = cvt_pk_bf16(yv[0] * (aa[0] + bflo(hp_[0])), yv[1] * (aa[1] + bfhi(hp_[0]))); o.y = cvt_pk_bf16(yv[2] * (aa[2] + bflo(hp_[1])), yv[3] * (aa[3] + bfhi(hp_[1]))); \
            __builtin_amdgcn_raw_buffer_store_b64(o, rW, voV, cmb ? (int)WS_V + (RS_ROW0(s) * DR + cgs) * 2 : sTrash, 0); } \
        } else { const u32x2 z2_ = {0u, 0u}; __builtin_amdgcn_raw_buffer_store_b64(z2_, rW, voH, sTrash, 0); __builtin_amdgcn_raw_buffer_store_b64(z2_, rW, voV, sTrash, 0); } \
        RS_LOADS((s) + RS_HD, 0); } while (0)
    RS_DMA(0); RS_DMA(1); RS_DMA(2); RS_DMA(3); RS_DMA(4);
    RS_LOADS(0, 0); RS_LOADS(1, 0); RS_LOADS(2, 0);
    asm volatile("s_waitcnt vmcnt(0)" ::: "memory"); __builtin_amdgcn_s_barrier(); asm volatile("" ::: "memory");
    f32x4 aA = {0.f, 0.f, 0.f, 0.f}, xA = aA, aB = aA, xB = aA, PA = aA, HA_ = aA, PB = aA, HB = aA;
    RS_MMA(0, aA, xA); RS_MMA(1, aB, xB); RS_EWA(0, aA, xA, PA, HA_);
#define RS_FLIP(s) RS_LOADS(s, 1); RS_LOADS((s) + 1, 1); RS_LOADS((s) + 2, 1); asm volatile("s_waitcnt vmcnt(0)" ::: "memory")
#define RS_EVEN(s, FC) RS_STEP(s, aA, xA, aB, xB, PB, HB, PA, HA_, FC)
#define RS_ODD(s, FC)  RS_STEP(s, aB, xB, aA, xA, PA, HA_, PB, HB, FC)
    for (int s = 0; s < 8; s += 2) { RS_EVEN(s, ); RS_ODD(s + 1, ); }
    RS_EVEN(8, RS_FLIP(8)); RS_ODD(9, );
    for (int s = 10; s < 144; s += 2) { RS_EVEN(s, ); RS_ODD(s + 1, ); }
    RS_EVEN(144, RS_FLIP(144)); RS_ODD(145, );
    for (int s = 146; s < 272; s += 2) { RS_EVEN(s, ); RS_ODD(s + 1, ); }
#undef RS_FLIP
#undef RS_EVEN
#undef RS_ODD
#undef RS_MMA
#undef RS_EWA
#undef RS_ROW0
#undef RS_TL
#undef RS_COMBINE
#undef RS_DMA
#undef RS_LOADS
#undef RS_STEP
}
__device__ __forceinline__ void cv_piece(Frame& F, int j, int n, CvDesc& d, int& k0, int& n0, bool& valid) {
    const int len0 = 2 * 3 * CV_IT_FFN, st0 = j == 0 ? 0 : len0;
    const int len1 = j == 0 ? CV_IT_WOUT + CV_IT_WIN + CV_IT_WOUT : 0, st1 = CV_N_FFN + CV_IT_WIN;
    const int len2 = CV_IT_QKV + CV_IT_WO, st2 = CV_N_FFN + CV_N_REC + (j == 0 ? 0 : len2);
    const int total = 2 * (len0 + len1 + len2);
    const int cw = F.cu * 2 + (F.wave - 6); int vs = cw + 512 * n; valid = vs < total; if (!valid) vs = total - 1;
    const int v = vs >> 1, h = vs & 1; const int it = v < len0 ? st0 + v : (v < len0 + len1 ? st1 + (v - len0) : st2 + (v - len0 - len1));
    int q; cv_matrix(F, it, d, q); k0 = (q / d.nblk) * 64 + 32 * h; n0 = (q % d.nblk) * 32;
}
__device__ __forceinline__ void scan_convert(Frame& F, int j) {
    const int lane = F.lane;
    LAS float* scr = (LAS float*)(F.lds + 2 * RS_RING + 6 * 4096 + (F.wave - 6) * 4224);
    float lA[16], lB[16], lC[16];
    bf16_t* wA = nullptr; bf16_t* wB = nullptr; bf16_t* wC = nullptr; int kA = 0, kB = 0, kC = 0;
#define CV_LOAD(t, l_, w_out_, k_out_) do { CvDesc d_; int k0_, n0_; bool ok_; cv_piece(F, j, (t), d_, k0_, n0_, ok_); \
        const float* w_ = d_.W + (size_t)(k0_ + (lane >> 5)) * d_.N + n0_ + (lane & 31); \
        _Pragma("unroll") for (int i = 0; i < 16; ++i) l_[i] = w_[(size_t)(2 * i) * d_.N]; \
        w_out_ = ok_ ? d_.WT + (size_t)cv_drow(d_.map, n0_) * d_.K + k0_ : nullptr; k_out_ = d_.K; } while (0)
#define CV_USE(l_, w_in_, k_in_) do { \
        _Pragma("unroll") for (int i = 0; i < 16; ++i) scr[(2 * i + (lane >> 5)) * 33 + (lane & 31)] = l_[i]; \
        LDS_WAIT(); asm volatile("" ::: "memory"); \
        if (w_in_ != nullptr) { const int c_ = lane & 3; \
            _Pragma("unroll") for (int jj = 0; jj < 2; ++jj) { const int n_ = (lane >> 2) + 16 * jj; const LAS float* s_ = scr + (8 * c_) * 33 + n_; \
                u32x4 o_; o_.x = cvt_pk_bf16(s_[0 * 33], s_[1 * 33]); o_.y = cvt_pk_bf16(s_[2 * 33], s_[3 * 33]); o_.z = cvt_pk_bf16(s_[4 * 33], s_[5 * 33]); o_.w = cvt_pk_bf16(s_[6 * 33], s_[7 * 33]); \
                *(GAS u32x4*)(w_in_ + (size_t)n_ * k_in_ + 8 * c_) = o_; } } } while (0)
#define CV_BAR() do { asm volatile("s_waitcnt lgkmcnt(0)" ::: "memory"); __builtin_amdgcn_s_barrier(); asm volatile("" ::: "memory"); } while (0)
    const int npc = j == 0 ? 196 : 152, niter = (npc - 3 + 2) / 3 + 1;
    CV_LOAD(0, lA, wA, kA); CV_BAR(); CV_LOAD(1, lB, wB, kB); CV_BAR();
    for (int i = 0; i < niter; ++i) {
        const int t = 2 + 3 * i;
        CV_LOAD(t, lC, wC, kC);     CV_USE(lA, wA, kA); CV_BAR();
        CV_LOAD(t + 1, lA, wA, kA); CV_USE(lB, wB, kB); CV_BAR();
        CV_LOAD(t + 2, lB, wB, kB); CV_USE(lC, wC, kC); CV_BAR();
    }
    for (int t = 2 + 3 * niter; t < 273; ++t) CV_BAR();
#undef CV_LOAD
#undef CV_USE
#undef CV_BAR
}
__device__ __forceinline__ void phase_scan(Frame& F, int j) {
    relaunder(F);
    const int k = F.wave >> 1, dir = F.wave & 1;
    const int xcd = F.cu & 7, lc = F.cu >> 3, pr = xcd + 8 * (lc >> 2), g = lc & 3, ct = 3 * g + k;
    const int b = pr >> 4, hb = pr & 15;
    if (k < 3) {
        if (ct < 11) { if (dir == 0) rec_sweep<0, true>(F, j, b, hb, ct, k); else rec_sweep<1, true>(F, j, b, hb, ct, k); }
        else         { if (dir == 0) rec_sweep<0, false>(F, j, b, hb, 10, k); else rec_sweep<1, false>(F, j, b, hb, 10, k); }
    } else {
        scan_convert(F, j);
    }
}

constexpr int ATT_KB = 16384, ATT_BUF = 2 * ATT_KB, ATT_NB = 3;
__device__ __forceinline__ unsigned cvtpk_s(float lo, float hi) { return pg8::cvt_pk_bf16(lo, hi); }
__device__ __forceinline__ int crow(int r, int hi) { return (r & 3) + 8 * (r >> 2) + 4 * hi; }
__device__ __forceinline__ void attn_unit(Frame& F, int b, int kvh, int qrow0, bool is_ctx, int q0, const float* sink) {
    const bf16_t* QK = (const bf16_t*)(F.ws + WS_BIG); const bf16_t* VT = (const bf16_t*)(F.ws + WS_HF); bf16_t* ATT = (bf16_t*)(F.ws + WS_Z);
    const int tid = F.tid, lane = F.lane, wave = F.wave, r32 = lane & 31, hi = lane >> 5;
    const int head = kvh * 4 + (wave >> 1), qi = 32 * (wave & 1) + r32;
    const int qrow = qrow0 + qi;
    int jl = 0, nloc = 0;
    if (!is_ctx) { jl = q0 >= 128 ? 0 : (q0 >= 64 ? 1 : 2); const int jh = q0 <= SEQ - 192 ? 4 : (q0 <= SEQ - 128 ? 3 : 2); nloc = jh - jl + 1; }
    const int nt = nloc + 4;
#define ATT_DMA(t, buf) do { const int t_ = (t); int krow0_; if (t_ < nloc) krow0_ = b * SEQ + q0 - 128 + 64 * (jl + t_); else krow0_ = ML + b * CTXL + 64 * (t_ - nloc); \
        LAS unsigned char* kb_ = F.lds + (buf) * ATT_BUF; \
        _Pragma("unroll") for (int i_ = 0; i_ < 2; ++i_) { const int c_ = (2 * wave + i_) * 64 + lane; const int kr_ = c_ >> 4, kp_ = c_ & 15, vd_ = c_ >> 3, vp_ = c_ & 7; \
            __builtin_amdgcn_global_load_lds((const unsigned*)(QK + (size_t)(krow0_ + kr_) * NQK + 2048 + kvh * 128 + 8 * (kp_ ^ (kr_ & 15))), (LAS unsigned*)(kb_ + (2 * wave + i_) * 1024), 16, 0, 0); \
            __builtin_amdgcn_global_load_lds((const unsigned*)(VT + (size_t)(kvh * 128 + vd_) * MT + krow0_ + 8 * (vp_ ^ ((vd_ >> 1) & 7))), (LAS unsigned*)(kb_ + ATT_KB + (2 * wave + i_) * 1024), 16, 0, 0); } } while (0)
    bf16x8 qf[8];
#pragma unroll
    for (int ds = 0; ds < 8; ++ds) qf[ds] = *(const bf16x8*)(QK + (size_t)qrow * NQK + head * 128 + 16 * ds + 8 * hi);
    const float sk2 = sink[head] * LOG2E;
    float mrun = sk2, lrun = hi == 0 ? 1.0f : 0.0f;
    f32x16 o[4];
#pragma unroll
    for (int d = 0; d < 4; ++d)
#pragma unroll
        for (int r = 0; r < 16; ++r) o[d][r] = 0.f;
    ATT_DMA(0, 0); ATT_DMA(nt > 1 ? 1 : 0, 1);
    int bcur = 0, bnxt = 2;
    for (int t = 0; t < nt; ++t) {
        asm volatile("s_waitcnt vmcnt(4)" ::: "memory");
        asm volatile("s_waitcnt lgkmcnt(0)" ::: "memory"); __builtin_amdgcn_s_barrier(); asm volatile("" ::: "memory");
        ATT_DMA(t + 2 < nt ? t + 2 : nt - 1, bnxt);
        const LAS unsigned char* kb = F.lds + bcur * ATT_BUF; const LAS unsigned char* vb = kb + ATT_KB;
        f32x16 p[2];
#pragma unroll
        for (int hf = 0; hf < 2; ++hf) {
#pragma unroll
            for (int r = 0; r < 16; ++r) p[hf][r] = 0.f;
            const int kv = 32 * hf + r32; bf16x8 kf[8];
#pragma unroll
            for (int ds = 0; ds < 8; ++ds) kf[ds] = *(const LAS bf16x8*)(kb + (kv * 16 + ((2 * ds + hi) ^ (kv & 15))) * 16);
            __builtin_amdgcn_sched_barrier(0);
#pragma unroll
            for (int ds = 0; ds < 8; ++ds) p[hf] = __builtin_amdgcn_mfma_f32_32x32x16_bf16(kf[ds], qf[ds], p[hf], 0, 0, 0);
        }
        const int jt = t < nloc ? jl + t : -1;
        if (jt == 0 || jt == 4) {
#pragma unroll
            for (int hf = 0; hf < 2; ++hf)
#pragma unroll
                for (int r = 0; r < 16; ++r) { const int kvi = 32 * hf + crow(r, hi); const bool ok = jt == 0 ? (kvi >= qi) : (kvi <= qi); if (!ok) p[hf][r] = -1e30f; }
        }
        float tm = p[0][0];
#pragma unroll
        for (int hf = 0; hf < 2; ++hf)
#pragma unroll
            for (int r = 0; r < 16; ++r) tm = fmaxf(tm, p[hf][r]);
        tm = fmaxf(tm, __shfl_xor(tm, 32));
        const float mnew = fmaxf(mrun, tm), sc = __builtin_amdgcn_exp2f(mrun - mnew);
        mrun = mnew; lrun *= sc;
#pragma unroll
        for (int d = 0; d < 4; ++d)
#pragma unroll
            for (int r = 0; r < 16; ++r) o[d][r] *= sc;
        float ls = 0.f;
#pragma unroll
        for (int hf = 0; hf < 2; ++hf)
#pragma unroll
            for (int r = 0; r < 16; ++r) { const float e = __builtin_amdgcn_exp2f(p[hf][r] - mnew); p[hf][r] = e; ls += e; }
        lrun += ls;
#pragma unroll
        for (int s = 0; s < 4; ++s) {
            const int hf = s >> 1, rb = 8 * (s & 1);
            u32x4 pw; pw.x = cvtpk_s(p[hf][rb + 0], p[hf][rb + 1]); pw.y = cvtpk_s(p[hf][rb + 2], p[hf][rb + 3]); pw.z = cvtpk_s(p[hf][rb + 4], p[hf][rb + 5]); pw.w = cvtpk_s(p[hf][rb + 6], p[hf][rb + 7]);
            const bf16x8 pf = __builtin_bit_cast(bf16x8, pw);
            u32x4 vw[4];
#pragma unroll
            for (int db = 0; db < 4; ++db) { const int d = 32 * db + r32; const int sw = (d >> 1) & 7;
                const int ua = 4 * s + hi, ub = 4 * s + 2 + hi;
                const u32x2 va = *(const LAS u32x2*)(vb + (d * 8 + ((ua >> 1) ^ sw)) * 16 + (ua & 1) * 8);
                const u32x2 vc = *(const LAS u32x2*)(vb + (d * 8 + ((ub >> 1) ^ sw)) * 16 + (ub & 1) * 8);
                vw[db].x = va.x; vw[db].y = va.y; vw[db].z = vc.x; vw[db].w = vc.y; }
            __builtin_amdgcn_sched_barrier(0);
#pragma unroll
            for (int db = 0; db < 4; ++db) o[db] = __builtin_amdgcn_mfma_f32_32x32x16_bf16(__builtin_bit_cast(bf16x8, vw[db]), pf, o[db], 0, 0, 0);
        }
        bcur = bcur == ATT_NB - 1 ? 0 : bcur + 1; bnxt = bnxt == ATT_NB - 1 ? 0 : bnxt + 1;
    }
    asm volatile("s_waitcnt lgkmcnt(0)" ::: "memory"); __builtin_amdgcn_s_barrier(); asm volatile("" ::: "memory");
    const float ltot = lrun + __shfl_xor(lrun, 32); const float inv = 1.0f / ltot;
    bf16_t* op = ATT + (size_t)qrow * D + head * 128;
#pragma unroll
    for (int db = 0; db < 4; ++db)
#pragma unroll
        for (int g = 0; g < 4; ++g) { u32x2 w; w.x = cvtpk_s(o[db][4 * g] * inv, o[db][4 * g + 1] * inv); w.y = cvtpk_s(o[db][4 * g + 2] * inv, o[db][4 * g + 3] * inv);
            *(u32x2*)(op + 32 * db + 8 * g + 4 * hi) = w; }
#undef ATT_DMA
}
__device__ __forceinline__ void phase_attn(Frame& F, int j, bool ctx_out) {
    relaunder(F);
    const float* sink = ((const float*)(GAS const float*)F.kp[I_SINK]) + j * 16;
    const int nunits = 1024 + (ctx_out ? 64 : 0);
    for (int u = F.cu; u < nunits; u += F.G) {
        if (u < 1024) { const int b = u >> 8, kvh = (u >> 6) & 3, qb = u & 63; attn_unit(F, b, kvh, b * SEQ + 64 * qb, false, 64 * qb, sink); }
        else { const int v = u - 1024, b = v >> 4, kvh = (v >> 2) & 3, qc = v & 3; attn_unit(F, b, kvh, ML + b * CTXL + 64 * qc, true, 0, sink); }
    }
}

#ifndef MK_PER_PHASE
#define MK_PER_PHASE 0
#endif
constexpr int NPHASE = 2 + 10 * DEPTH;
#ifndef EN
#define EN 0xffff
#endif
#ifndef DUP
#define DUP 0
#endif
struct Args { const float* in[25]; float* out; unsigned char* ws; int ph_lo, ph_hi; };
__global__ void __launch_bounds__(NWAVES * 64, 2) fwd_kernel(Args args) {
    extern __shared__ __attribute__((aligned(16))) unsigned char lds[];
    Frame F;
    F.lds = (LAS unsigned char*)lds;
    F.tid = threadIdx.x; F.lane = F.tid & 63; F.wave = __builtin_amdgcn_readfirstlane(F.tid >> 6);
    F.G = gridDim.x; F.gw = blockIdx.x * NWAVES + F.wave; F.ngw = F.G * NWAVES;
    F.kp = kargs(); F.ws = (unsigned char*)(GAS unsigned char*)F.kp[26]; F.cu = blockIdx.x;
    volatile LAS unsigned* MISC = (volatile LAS unsigned*)(F.lds + MISC_OFF);
    for (int u = F.tid; u < (LDS_BYTES - LDSCTL_OFF) / 4; u += NWAVES * 64) ((LAS unsigned*)(F.lds + LDSCTL_OFF))[u] = 0u;
    __syncthreads();
    XcdBarrier bar = xcd_barrier_post((unsigned*)(F.ws + WS_CTL) + CW_BAR, MISC + 8);
#if MK_PER_PHASE
    const int lo = (int)(unsigned)F.kp[27], hi = (int)(unsigned)(F.kp[27] >> 32);
#define IN(k) (lo <= (k) && (k) < hi)
#define SEAM() do { } while (0)
#else
#define IN(k) true
#define SEAM() do { XcdBarrier b2_; b2_.bar = (unsigned*)(F.ws + WS_CTL) + CW_BAR; b2_.x = xb_xcc_id(); b2_.st = MISC + 8; xcd_barrier(b2_); } while (0)
#endif
#define modv ((float*)(F.ws + WS_MODV))
#define U ((bf16_t*)(F.ws + WS_U))
#define BIG ((bf16_t*)(F.ws + WS_BIG))
#define HA ((float*)(F.ws + WS_HA))
#define cu (F.cu)
#define modL (modv + (size_t)L * 5 * MODN)

    if (IN(0)) { if (EN&1) phase_p0a(F); if (DUP&1) { __syncthreads(); phase_p0a(F); } SEAM(); }
    if (IN(1)) { if (EN&2) phase_rows<0>(F, MT, nullptr, nullptr, modv, 0, D); SEAM(); }
    for (int L = 0; L < DEPTH; ++L) {
        const int base = 2 + 10 * L, j = L >> 1; const bool last = (L == DEPTH - 1), rec = (L & 1) == 0; const int Mrows = last ? ML : MT;
        if (IN(base + 0)) {
            if (rec) { if (EN&4) { relaunder(F);
                pg8::Gemm g{U, (const bf16_t*)(F.ws + WS_WIN) + (size_t)j * FF * D, MT, FF, D}; pg8::StaticOrder S; S.init(MT, FF, F.G, cu);
                pg8::EpiBf16 E{BIG, FF, 11};
                pg8::gemm_phase<pg8::EpiBf16, pg8::StaticOrder, PG8_ALIGN, PG8_SP2>(F.lds + RING_OFF, g, S, E); }
            } else {
                if (EN&8) { relaunder(F); const bf16_t* Wq = (const bf16_t*)(F.ws + WS_WQKV) + (size_t)j * NQKV * D; pg8::Gemm g{U, Wq, MT, NQK, D}; pg8::StaticOrder S; S.init(MT, NQK, F.G, cu);
                  pg8::EpiQK E{BIG, (const f32x2*)(F.ws + WS_ROPE)};
                  pg8::gemm_phase<pg8::EpiQK, pg8::StaticOrder, PG8_ALIGN, PG8_SP2>(F.lds + RING_OFF, g, S, E); }
                if (EN&16) { relaunder(F); const bf16_t* Wq = (const bf16_t*)(F.ws + WS_WQKV) + (size_t)j * NQKV * D; pg8::Gemm g{Wq + (size_t)NQK * D, U, NVV, MT, D}; pg8::StaticOrder S; S.init(NVV, MT, F.G, (cu + 88) & 255);
                  pg8::EpiBf16 E{(bf16_t*)(F.ws + WS_HF), MT, 0};
                  pg8::gemm_phase<pg8::EpiBf16, pg8::StaticOrder, PG8_ALIGN, PG8_SP2>(F.lds + RING_OFF, g, S, E); }
            }
            SEAM();
        }
        if (rec) {
            if (IN(base + 1)) { if (EN&32) phase_conv(F, j); if (DUP&32) phase_conv(F, j); SEAM(); }
            if (IN(base + 2)) { if (EN&64) phase_scan(F, j); if (DUP&64) phase_scan(F, j); SEAM(); }
        } else {
            if (IN(base + 2)) { for (int rep = 0; rep < ((DUP&128) ? 2 : 1); ++rep) { if (EN&128) phase_attn(F, j, !last); } SEAM(); }
        }
        if (IN(base + 3)) { if (EN&256) { relaunder(F);
            pg8::Gemm g; if (rec) g = pg8::Gemm{(const bf16_t*)(F.ws + WS_V), (const bf16_t*)(F.ws + WS_WOUT) + (size_t)j * D * DR, Mrows, D, DR};
            else g = pg8::Gemm{(const bf16_t*)(F.ws + WS_Z), (const bf16_t*)(F.ws + WS_WO) + (size_t)j * D * D, Mrows, D, D};
            pg8::TailOrder S; S.init(D, g.K, F.G, cu, !last);
            const float* st_ = (const float*)(F.ws + WS_STATS);
            pg8::EpiRes E{HA, D, modL + 2 * D, MODN, (float*)(F.ws + WS_SLAB), L == 0 ? (const float*)(GAS const float*)F.kp[I_X] : (const float*)HA, L == 0 ? nullptr : st_,
                          ((const float*)(GAS const float*)F.kp[I_LNFG]) + (size_t)(L > 0 ? L - 1 : 0) * D, ((const float*)(GAS const float*)F.kp[I_LNFB]) + (size_t)(L > 0 ? L - 1 : 0) * D};
            pg8::gemm_phase<pg8::EpiRes, pg8::TailOrder, PG8_ALIGN, PG8_SP2>(F.lds + RING_OFF, g, S, E); }
            SEAM();
        }
        if (IN(base + 4)) { if (EN&512) phase_rows<1>(F, Mrows, ((const float*)(GAS const float*)F.kp[I_LNMG]) + (size_t)L * D, ((const float*)(GAS const float*)F.kp[I_LNMB]) + (size_t)L * D, modL, 3 * D, 4 * D, last ? nullptr : (const float*)(F.ws + WS_SLAB), modL + 4 * MODN + 2 * D); SEAM(); }
        if (IN(base + 5)) { if (EN&1024) { relaunder(F);
            pg8::Gemm g{U, (const bf16_t*)(F.ws + WS_WGU) + (size_t)L * (2 * FF) * D, Mrows, 2 * FF, D}; pg8::StaticOrder S; S.init(Mrows, 2 * FF, F.G, cu);
            pg8::EpiGU E{BIG, FF};
            pg8::gemm_phase<pg8::EpiGU, pg8::StaticOrder, PG8_ALIGN, PG8_SP2>(F.lds + RING_OFF, g, S, E); }
            SEAM();
        }
        if (IN(base + 6)) { if (EN&2048) { relaunder(F);
            pg8::Gemm g{BIG, (const bf16_t*)(F.ws + WS_WD) + (size_t)L * D * FF, Mrows, D, FF}; pg8::TailOrder S; S.init(D, FF, F.G, cu, !last);
            pg8::EpiRes E{HA, D, modL + 5 * D, MODN, (float*)(F.ws + WS_SLAB), (const float*)HA, (const float*)(F.ws + WS_STATS),
                          ((const float*)(GAS const float*)F.kp[I_LNMG]) + (size_t)L * D, ((const float*)(GAS const float*)F.kp[I_LNMB]) + (size_t)L * D};
            pg8::gemm_phase<pg8::EpiRes, pg8::TailOrder, PG8_ALIGN, PG8_SP2>(F.lds + RING_OFF, g, S, E); }
            SEAM();
        }
        if (IN(base + 7)) { if (EN&4096) {
            if (last) phase_rows<2>(F, ML, ((const float*)(GAS const float*)F.kp[I_LNFG]) + (size_t)L * D, ((const float*)(GAS const float*)F.kp[I_LNFB]) + (size_t)L * D, nullptr, 0, 0);
            else { phase_rows<1>(F, MT, ((const float*)(GAS const float*)F.kp[I_LNFG]) + (size_t)L * D, ((const float*)(GAS const float*)F.kp[I_LNFB]) + (size_t)L * D, modv + (size_t)(L + 1) * 5 * MODN, 0, D, (const float*)(F.ws + WS_SLAB), modL + 4 * MODN + 5 * D); } }
            if (!last) SEAM();
        }
    }
#undef IN
#undef SEAM
#undef modv
#undef U
#undef BIG
#undef HA
#undef cu
#undef modL
}

extern "C" void kernel_launch(void* const* d_in, const int* in_sizes, int n_in, void* d_out, int out_size, void* d_ws, size_t ws_size, hipStream_t stream) {
    static int grid = 0;
    if (grid == 0) {
        if (n_in != 25 || out_size != ML * D || ws_size < WS_END) { fprintf(stderr, "kernel_launch: unexpected shapes / workspace (n_in %d out %d ws %zu need %zu)\n", n_in, out_size, ws_size, (size_t)WS_END); grid = -1; return; }
        int dev = 0, cus = 0;
        if (hipGetDevice(&dev) != hipSuccess || hipDeviceGetAttribute(&cus, hipDeviceAttributeMultiprocessorCount, dev) != hipSuccess) { grid = -1; return; }
        if (hipFuncSetAttribute((const void*)fwd_kernel, hipFuncAttributeMaxDynamicSharedMemorySize, LDS_BYTES) != hipSuccess) { fprintf(stderr, "kernel_launch: hipFuncSetAttribute failed\n"); grid = -1; return; }
        int per_cu = 0;
        if (hipOccupancyMaxActiveBlocksPerMultiprocessor(&per_cu, (const void*)fwd_kernel, NWAVES * 64, LDS_BYTES) != hipSuccess || per_cu < 1) { fprintf(stderr, "kernel_launch: occupancy query says %d\n", per_cu); }
        (void)hipGetLastError();
        grid = cus < 256 ? cus : 256;
    }
    if (grid < 0) return;
    if (hipMemsetAsync((char*)d_ws + WS_CTL, 0, CTL_ZERO_BYTES, stream) != hipSuccess) return;
    Args a{};
    for (int i = 0; i < 25; ++i) a.in[i] = (const float*)d_in[i];
    a.out = (float*)d_out; a.ws = (unsigned char*)d_ws;
#if MK_PER_PHASE
    for (int p = 0; p < NPHASE; ++p) { a.ph_lo = p; a.ph_hi = p + 1; hipLaunchKernelGGL(fwd_kernel, dim3(grid), dim3(NWAVES * 64), LDS_BYTES, stream, a); }
#else
    a.ph_lo = 0; a.ph_hi = NPHASE;
    hipLaunchKernelGGL(fwd_kernel, dim3(grid), dim3(NWAVES * 64), LDS_BYTES, stream, a);
#endif
    const hipError_t le = hipPeekAtLastError();
    if (le != hipSuccess) fprintf(stderr, "kernel_launch: launch failed: %s\n", hipGetErrorName(le));
}
```

```cpp
#include <hip/hip_runtime.h>
#include <cstdint>
#include <cstdio>

#define LAS __attribute__((address_space(3)))
#define GAS __attribute__((address_space(1)))
typedef unsigned short bf16_t;
typedef short bf16x8 __attribute__((ext_vector_type(8)));
typedef short bf16x4 __attribute__((ext_vector_type(4)));
typedef float f32x4 __attribute__((ext_vector_type(4)));
typedef float f32x2 __attribute__((ext_vector_type(2)));
typedef float f32x16 __attribute__((ext_vector_type(16)));
typedef unsigned u32x4 __attribute__((ext_vector_type(4)));
typedef unsigned u32x2 __attribute__((ext_vector_type(2)));

constexpr int D = 2048, SEQ = 4096, CTXL = 256, NBATCH = 4, ML = NBATCH * SEQ, MC = NBATCH * CTXL, MT = ML + MC;
constexpr int DR = 2816, FF = 5632, NQK = 2560, NVV = 512, NQKV = 3072, MODN = 6 * D, DEPTH = 4, BW = 176, ZP = 3072, NWAVES = 8;
constexpr float ALPHA = 1.6817928305074292f, LN_EPS = 1e-5f, LOG2E = 1.4426950408889634f;
constexpr float QSCALE = 0.08838834764831845f * 1.4426950408889634f;

constexpr size_t MiB = 1u << 20;
constexpr size_t WS_CTL = 0, CTL_ZERO_BYTES = 1 * MiB;
constexpr size_t WS_MODV = 1 * MiB, WS_ROPE = 2 * MiB, WS_STATS = 3 * MiB;
constexpr size_t WS_WGU = 4 * MiB;
constexpr size_t WS_WD = WS_WGU + 4 * (size_t)(2 * FF) * D * 2;
constexpr size_t WS_WIN = WS_WD + 4 * (size_t)D * FF * 2;
constexpr size_t WS_WOUT = WS_WIN + 2 * (size_t)FF * D * 2;
constexpr size_t WS_WQKV = WS_WOUT + 2 * (size_t)D * DR * 2;
constexpr size_t WS_WO = WS_WQKV + 2 * (size_t)NQKV * D * 2;
constexpr size_t WS_HA = WS_WO + 2 * (size_t)D * D * 2;
constexpr size_t WS_U = WS_HA + (size_t)MT * D * 4;
constexpr size_t WS_BIG = WS_U + (size_t)MT * D * 2;
constexpr size_t WS_Z = WS_BIG + (size_t)MT * FF * 2;
constexpr size_t WS_V = WS_Z + (size_t)MT * ZP * 2;
constexpr size_t WS_HF = WS_V + (size_t)MT * DR * 2;
constexpr size_t WS_SLAB = WS_HF + (size_t)MT * DR * 4;
constexpr size_t WS_END = WS_SLAB + 8 * (size_t)MC * D * 4;
namespace pg8 {
#define PG8_LAS __attribute__((address_space(3)))
typedef unsigned short bf16_t;
typedef short bf16x8 __attribute__((ext_vector_type(8)));
typedef float f32x4 __attribute__((ext_vector_type(4)));
typedef unsigned u32x4 __attribute__((ext_vector_type(4)));
constexpr int BM = 256, BK = 64, HALF = 128, HTB = HALF * BK * 2  , STAGE_BYTES = 8 * HTB, NXCD = 8, WGM = 8;

__host__ __device__ __forceinline__ int lds_byte(int r, int c) { const int st = (r >> 4) * 2 + (c >> 5), rr = r & 15, cc = c & 31, ob = rr * 64 + cc * 2; return st * 1024 + (ob ^ (((ob >> 9) & 1) << 5)); }
__host__ __device__ __forceinline__ void stage_rc(int b, int& R, int& C) { const int st = b / 1024, sb = b % 1024, swz = sb ^ (((sb >> 9) & 1) << 5); R = (st >> 1) * 16 + swz / 64; C = (st & 1) * 32 + (swz % 64) / 2; }
__host__ __device__ __forceinline__ int perm32(int rho) { const int n = rho >> 4, i = rho & 15; return 8 * (i >> 2) + 4 * n + (i & 3); }

struct Unit { int pm, pn, kt0, nt, q; };
struct Gemm { const bf16_t* A; const bf16_t* Bt; int M, N, K; };

struct StaticOrder {
    int nM, nN, nwg, G, c;
    __host__ __device__ void init(int M, int N, int G_, int c_) { nM = M / BM; nN = N / BM; nwg = nM * nN; G = G_; c = c_; }
    __host__ __device__ __forceinline__ bool next(int i, Unit& u) const {
        u.kt0 = 0; u.nt = 0; u.q = 0; u.pm = 0; u.pn = 0;
        const long L = (long)i * G + c; if (L >= nwg) return false;
        int wgid = (int)L; { const int q = nwg / NXCD, r = nwg % NXCD, xcd = wgid % NXCD, off = wgid / NXCD; wgid = (xcd < r ? xcd * (q + 1) : r * (q + 1) + (xcd - r) * q) + off; }
        const int nig = WGM * nN, gid = wgid / nig, fm = gid * WGM, gsz = (nM - fm) < WGM ? (nM - fm) : WGM;
        u.pm = fm + ((wgid % nig) % gsz); u.pn = (wgid % nig) / gsz; u.kt0 = 0; u.nt = 0; u.q = 0; return true;
    }
    __device__ __forceinline__ void a_ready(const Unit&) const {}
    __device__ __forceinline__ void done(const Unit&) const {}
};

struct TailOrder {
    StaticOrder S; int c, T; bool tail;
    __host__ __device__ void init(int N, int K, int G_, int c_, bool tail_) { S.init(ML, N, G_, c_); c = c_; T = K / BK; tail = tail_; }
    __device__ __forceinline__ bool next(int i, Unit& u) const {
        const bool first = tail && (((c >> 3) & 1) != 0); const int iu = first ? i - 1 : i;
        Unit v; const bool okS = S.next((iu >= 0 && iu < 2) ? iu : 0, v);
        const int tile = c >> 3, q = c & 7, be = (T >> 3) & ~1, rem2 = (T - 8 * be) >> 1;
        const bool isTail = tail && (first ? i == 0 : i == 2);
        u.pm = isTail ? 64 + (tile >> 3) : v.pm; u.pn = isTail ? (tile & 7) : v.pn;
        u.nt = isTail ? be + (q < rem2 ? 2 : 0) : 0; u.kt0 = isTail ? q * be + 2 * (q < rem2 ? q : rem2) : 0; u.q = isTail ? q : 0;
        return isTail ? true : ((iu >= 0 && iu < 2) ? okS : false);
    }
    __device__ __forceinline__ void a_ready(const Unit&) const {}
    __device__ __forceinline__ void done(const Unit&) const {}
};

typedef __bf16 bf16x2_t __attribute__((ext_vector_type(2))); typedef float f32x2_t __attribute__((ext_vector_type(2)));
__device__ __forceinline__ unsigned cvt_pk_bf16(float lo, float hi) { f32x2_t v = {lo, hi}; bf16x2_t b = __builtin_convertvector(v, bf16x2_t); return __builtin_bit_cast(unsigned, b); }
__device__ __forceinline__ float sigmoid_fast(float x) { return __builtin_amdgcn_rcpf(1.0f + __builtin_amdgcn_exp2f(-1.4426950408889634f * x)); }
__device__ __forceinline__ float gelu_tanh_fast(float x) { const float y = x * (1.5957691216057308f + 0.07135481627159498f * x * x); return x * sigmoid_fast(y); }
__device__ __forceinline__ u32x4 pack8(const f32x4 a, const f32x4 b) { u32x4 w; w.x = cvt_pk_bf16(a[0], a[1]); w.y = cvt_pk_bf16(a[2], a[3]); w.z = cvt_pk_bf16(b[0], b[1]); w.w = cvt_pk_bf16(b[2], b[3]); return w; }

struct EpiBf16 {
    static constexpr bool PERM = true, AFTER_DRAIN = false;
    bf16_t* O; int ldc; int gelu_tiles;
    __device__ __forceinline__ void operator()(const f32x4 (&acc)[2][2][4][2], const Unit& u, int wr, int wc, int fr, int fq) const {
        const int row0 = u.pm * BM + wr * 64 + fr, col0 = u.pn * BM + wc * 32 + 8 * fq; const bool act = u.pn < gelu_tiles;
#pragma unroll
        for (int ai = 0; ai < 2; ++ai)
#pragma unroll
            for (int m = 0; m < 4; ++m) { bf16_t* rowp = O + (size_t)(row0 + ai * HALF + m * 16) * ldc + col0;
#pragma unroll
                for (int bj = 0; bj < 2; ++bj) { f32x4 v0 = acc[ai][bj][m][0], v1 = acc[ai][bj][m][1];
                    if (act) {
#pragma unroll
                        for (int e = 0; e < 4; ++e) { v0[e] = gelu_tanh_fast(v0[e]); v1[e] = gelu_tanh_fast(v1[e]); } }
                    *(u32x4*)(rowp + bj * HALF) = pack8(v0, v1); } }
    }
};
struct EpiGU {
    static constexpr bool PERM = true, AFTER_DRAIN = false;
    bf16_t* O; int ldc;
    __device__ __forceinline__ void operator()(const f32x4 (&acc)[2][2][4][2], const Unit& u, int wr, int wc, int fr, int fq) const {
        const int row0 = u.pm * BM + wr * 64 + fr, col0 = u.pn * HALF + wc * 32 + 8 * fq;
#pragma unroll
        for (int ai = 0; ai < 2; ++ai)
#pragma unroll
            for (int m = 0; m < 4; ++m) { f32x4 o0, o1;
#pragma unroll
                for (int e = 0; e < 4; ++e) { const float g0 = acc[ai][0][m][0][e], g1 = acc[ai][0][m][1][e];
                    o0[e] = g0 * sigmoid_fast(g0) * acc[ai][1][m][0][e]; o1[e] = g1 * sigmoid_fast(g1) * acc[ai][1][m][1][e]; }
                *(u32x4*)(O + (size_t)(row0 + ai * HALF + m * 16) * ldc + col0) = pack8(o0, o1); }
    }
};
struct EpiRes {
    static constexpr bool PERM = false, AFTER_DRAIN = false;
    float* HA; int ldc; const float* gate;
    int gate_ld; float* slab;
    const float* src; const float* stats; const float* gam; const float* bet;
    __device__ __forceinline__ void operator()(const f32x4 (&acc)[2][2][4][2], const Unit& u, int wr, int wc, int fr, int fq) const {
        const int col0 = u.pn * BM + wc * 32 + 4 * fq;
        if (u.nt != 0) {
#pragma unroll
            for (int ai = 0; ai < 2; ++ai)
#pragma unroll
                for (int m = 0; m < 4; ++m) { float* p = slab + ((size_t)u.q * MC + (size_t)((u.pm - 64) * BM + ai * HALF + wr * 64 + m * 16 + fr)) * ldc + col0;
#pragma unroll
                    for (int bj = 0; bj < 2; ++bj)
#pragma unroll
                        for (int n = 0; n < 2; ++n) *(f32x4*)(p + bj * HALF + n * 16) = acc[ai][bj][m][n]; }
            return;
        }
        const int r = u.pm < 64 ? (u.pm >> 4) : 4; const float* g = gate + (size_t)r * gate_ld + col0;
        f32x4 gv[2][2], ga[2][2], be[2][2]; const bool ln = stats != nullptr;
#pragma unroll
        for (int bj = 0; bj < 2; ++bj)
#pragma unroll
            for (int n = 0; n < 2; ++n) { gv[bj][n] = *(const f32x4*)(g + bj * HALF + n * 16);
                ga[bj][n] = ln ? *(const f32x4*)(gam + col0 + bj * HALF + n * 16) * 1.6817928305074292f : (f32x4){1.6817928305074292f, 1.6817928305074292f, 1.6817928305074292f, 1.6817928305074292f};
                be[bj][n] = ln ? *(const f32x4*)(bet + col0 + bj * HALF + n * 16) * 1.6817928305074292f : (f32x4){0.f, 0.f, 0.f, 0.f}; }
#pragma unroll
        for (int ai = 0; ai < 2; ++ai)
#pragma unroll
            for (int m = 0; m < 4; ++m) { const size_t ro = (size_t)(u.pm * BM + ai * HALF + wr * 64 + m * 16 + fr); const float* sp = src + ro * ldc + col0; float* p = HA + ro * ldc + col0; f32x4 hv[2][2];
                float mean = 0.f, rstd = 1.f; if (ln) { const f32x2_t st = *(const f32x2_t*)(stats + 2 * ro); mean = st.x; rstd = st.y; }
#pragma unroll
                for (int bj = 0; bj < 2; ++bj)
#pragma unroll
                    for (int n = 0; n < 2; ++n) hv[bj][n] = *(const f32x4*)(sp + bj * HALF + n * 16);
#pragma unroll
                for (int bj = 0; bj < 2; ++bj)
#pragma unroll
                    for (int n = 0; n < 2; ++n) *(f32x4*)(p + bj * HALF + n * 16) = (hv[bj][n] - mean) * rstd * ga[bj][n] + be[bj][n] + gv[bj][n] * acc[ai][bj][m][n];
                if (m & 1) asm volatile("" ::: "memory"); }
    }
};
struct EpiQK {
    static constexpr bool PERM = true, AFTER_DRAIN = false;
    bf16_t* O; const f32x2* tab;
    __device__ __forceinline__ void operator()(const f32x4 (&acc)[2][2][4][2], const Unit& u, int wr, int wc, int fr, int fq) const {
        const int row0 = u.pm * BM + wr * 64 + fr; const bool latent = u.pm < 64; const float qs = u.pn < 8 ? 0.12751743082459868f : 1.0f;
        const int colA = u.pn * BM + (wc >> 1) * HALF + 32 * (wc & 1) + 8 * fq;
#pragma unroll
        for (int ai = 0; ai < 2; ++ai)
#pragma unroll
            for (int m = 0; m < 4; ++m) { const int row = row0 + ai * HALF + m * 16; const int t = row & 4095; const int pos = (wc & 1) ? (t & 63) : (t >> 6);
                const f32x4* tp = (const f32x4*)(tab + pos * 32 + 8 * fq); f32x4 o1[2], o2[2];
#pragma unroll
                for (int n = 0; n < 2; ++n) { f32x4 cs0 = (f32x4){1.f, 0.f, 1.f, 0.f}, cs1 = cs0;
                    if (latent) { cs0 = tp[2 * n]; cs1 = tp[2 * n + 1]; }
                    const f32x4 t1 = acc[ai][0][m][n], t2 = acc[ai][1][m][n];
                    o1[n][0] = (t1[0] * cs0[0] - t2[0] * cs0[1]) * qs; o2[n][0] = (t2[0] * cs0[0] + t1[0] * cs0[1]) * qs;
                    o1[n][1] = (t1[1] * cs0[2] - t2[1] * cs0[3]) * qs; o2[n][1] = (t2[1] * cs0[2] + t1[1] * cs0[3]) * qs;
                    o1[n][2] = (t1[2] * cs1[0] - t2[2] * cs1[1]) * qs; o2[n][2] = (t2[2] * cs1[0] + t1[2] * cs1[1]) * qs;
                    o1[n][3] = (t1[3] * cs1[2] - t2[3] * cs1[3]) * qs; o2[n][3] = (t2[3] * cs1[2] + t1[3] * cs1[3]) * qs; }
                bf16_t* rowp = O + (size_t)row * NQK + colA;
                *(u32x4*)(rowp) = pack8(o1[0], o1[1]); *(u32x4*)(rowp + 64) = pack8(o2[0], o2[1]); }
    }
};

template <class Epi, class Sched, bool ALIGN_EPI = false, bool SP2 = false>
__device__ __forceinline__ void gemm_phase(PG8_LAS unsigned char* lds, const Gemm g, const Sched& S, const Epi& E) {
    int tid_ = threadIdx.x; asm volatile("" : "+v"(tid_));
    const int tid = tid_, wid = __builtin_amdgcn_readfirstlane(tid >> 6), lane = tid & 63, wr = wid >> 2, wc = wid & 3, fr = lane & 15, fq = lane >> 4;
    const int K = g.K, nt = K / BK;
    unsigned voffA[2], voffB[2];
#pragma unroll
    for (int i = 0; i < 2; ++i) { int R, C; stage_rc(tid * 16 + i * 8192, R, C); const int Rb = Epi::PERM ? ((R & ~31) + perm32(R & 31)) : R;
        voffA[i] = (unsigned)(R * K + C) * 2u; voffB[i] = (unsigned)(Rb * K + C) * 2u; }
    const size_t kstep = (size_t)(BK * 2);
    const size_t hstep = (size_t)HALF * K * 2;
    const size_t tstep = 2 * hstep;
    const unsigned ldsw = (unsigned)wid * 1024u;
    const int aoff = lds_byte(wr * 64 + fr, fq * 8), boff = lds_byte(wc * 32 + fr, fq * 8);
#define PG8_SA(b, h) (((b) * 2 + (h)) * HTB)
#define PG8_SB(b, h) ((4 + (b) * 2 + (h)) * HTB)
#define PG8_STAGE(bufoff, gbase, voff) do { _Pragma("unroll") for (int _i = 0; _i < 2; ++_i) \
        __builtin_amdgcn_global_load_lds((const unsigned*)((const char*)(gbase) + (voff)[_i]), (PG8_LAS unsigned*)(lds + (bufoff) + ldsw + _i * 8192), 16, 0, 0); } while (0)
#define PG8_LDA(dst, b, h) do { _Pragma("unroll") for (int m = 0; m < 4; ++m) _Pragma("unroll") for (int k = 0; k < 2; ++k) dst[m][k] = *(const PG8_LAS bf16x8*)(lds + PG8_SA(b, h) + aoff + m * 2048 + k * 1024); } while (0)
#define PG8_LDB(dst, b, h) do { _Pragma("unroll") for (int n = 0; n < 2; ++n) _Pragma("unroll") for (int k = 0; k < 2; ++k) dst[n][k] = *(const PG8_LAS bf16x8*)(lds + PG8_SB(b, h) + boff + n * 2048 + k * 1024); } while (0)
#define PG8_MMA(ai, bj, At, Bt) do { __builtin_amdgcn_s_setprio(1); _Pragma("unroll") for (int m = 0; m < 4; ++m) _Pragma("unroll") for (int n = 0; n < 2; ++n) _Pragma("unroll") for (int k = 0; k < 2; ++k) \
        acc[ai][bj][m][n] = __builtin_amdgcn_mfma_f32_16x16x32_bf16(Bt[n][k], At[m][k], acc[ai][bj][m][n], 0, 0, 0); __builtin_amdgcn_s_setprio(0); } while (0)
#define PG8_WAIT_V(n) asm volatile("s_waitcnt vmcnt(" #n ")" ::: "memory")
#define PG8_WAIT_L(n) asm volatile("s_waitcnt lgkmcnt(" #n ")" ::: "memory")
#define PG8_BAR __builtin_amdgcn_s_barrier()
#define PG8_SCHED __builtin_amdgcn_sched_barrier(0)
    Unit cur, nxt; int ui = 0;
    if (!S.next(0, cur)) return;
    f32x4 acc[2][2][4][2];
#pragma unroll
    for (int a = 0; a < 2; ++a)
#pragma unroll
        for (int b = 0; b < 2; ++b)
#pragma unroll
            for (int m = 0; m < 4; ++m)
#pragma unroll
                for (int n = 0; n < 2; ++n) acc[a][b][m][n] = (f32x4){0.f, 0.f, 0.f, 0.f};
    bf16x8 At[4][2], B0[2][2], B1[2][2];
    const char* cA = (const char*)g.A + (size_t)cur.pm * tstep + (size_t)cur.kt0 * kstep; const char* cB = (const char*)g.Bt + (size_t)cur.pn * tstep + (size_t)cur.kt0 * kstep;
    S.a_ready(cur);
    if constexpr (SP2) {
        PG8_STAGE(PG8_SB(0, 0), cB, voffB); PG8_STAGE(PG8_SB(0, 1), cB + hstep, voffB); PG8_STAGE(PG8_SA(0, 0), cA, voffA); PG8_STAGE(PG8_SA(0, 1), cA + hstep, voffA);
        if (wr == 1) PG8_BAR;
        PG8_WAIT_V(2); PG8_BAR;
        PG8_STAGE(PG8_SB(1, 0), cB + kstep, voffB); PG8_STAGE(PG8_SA(1, 0), cA + kstep, voffA); PG8_STAGE(PG8_SB(1, 1), cB + hstep + kstep, voffB);
        PG8_WAIT_V(6); PG8_BAR;
    } else {
        PG8_STAGE(PG8_SB(0, 0), cB, voffB); PG8_STAGE(PG8_SA(0, 0), cA, voffA); PG8_STAGE(PG8_SB(0, 1), cB + hstep, voffB); PG8_STAGE(PG8_SA(0, 1), cA + hstep, voffA);
        if (wr == 1) PG8_BAR;
        PG8_WAIT_V(4); PG8_BAR;
        PG8_STAGE(PG8_SB(1, 0), cB + kstep, voffB); PG8_STAGE(PG8_SA(1, 0), cA + kstep, voffA); PG8_STAGE(PG8_SB(1, 1), cB + hstep + kstep, voffB);
        PG8_WAIT_V(6); PG8_BAR;
    }
    for (;;) {
        const bool has_next = S.next(ui + 1, nxt);
        const char* nA = has_next ? (const char*)g.A + (size_t)nxt.pm * tstep + (size_t)nxt.kt0 * kstep : cA; const char* nB = has_next ? (const char*)g.Bt + (size_t)nxt.pn * tstep + (size_t)nxt.kt0 * kstep : cB;
        const int ntu = cur.nt ? cur.nt : nt;
        for (int t = 0; t < ntu; t += 2) {
            const bool last = (t == ntu - 2);
            const char* a1 = cA + (size_t)(t + 1) * kstep;
            const char* a2 = last ? nA : cA + (size_t)(t + 2) * kstep; const char* b2 = last ? nB : cB + (size_t)(t + 2) * kstep;
            const char* a3 = a2 + kstep; const char* b3 = b2 + kstep;
            if (last && has_next) S.a_ready(nxt);
            if constexpr (SP2) {
            PG8_LDB(B0, 0, 0); PG8_LDB(B1, 0, 1); PG8_SCHED; PG8_LDA(At, 0, 0); PG8_STAGE(PG8_SA(1, 1), a1 + hstep, voffA);
            PG8_WAIT_V(8); PG8_WAIT_L(0); PG8_BAR; PG8_MMA(0, 0, At, B0); PG8_MMA(0, 1, At, B1); PG8_BAR; PG8_SCHED;
            PG8_LDA(At, 0, 1); PG8_STAGE(PG8_SB(0, 0), b2, voffB); PG8_STAGE(PG8_SB(0, 1), b2 + hstep, voffB); PG8_STAGE(PG8_SA(0, 0), a2, voffA);
            PG8_WAIT_V(8); PG8_WAIT_L(0); PG8_BAR; PG8_MMA(1, 0, At, B0); PG8_MMA(1, 1, At, B1); PG8_BAR; PG8_SCHED;
            PG8_LDB(B0, 1, 0); PG8_LDB(B1, 1, 1); PG8_SCHED; PG8_LDA(At, 1, 0); PG8_STAGE(PG8_SA(0, 1), a2 + hstep, voffA);
            PG8_WAIT_V(8); PG8_WAIT_L(0); PG8_BAR; PG8_MMA(0, 0, At, B0); PG8_MMA(0, 1, At, B1); PG8_BAR; PG8_SCHED;
            PG8_LDA(At, 1, 1); PG8_STAGE(PG8_SB(1, 0), b3, voffB); PG8_STAGE(PG8_SB(1, 1), b3 + hstep, voffB); PG8_STAGE(PG8_SA(1, 0), a3, voffA);
            PG8_WAIT_V(8); PG8_WAIT_L(0); PG8_BAR; PG8_MMA(1, 0, At, B0); PG8_MMA(1, 1, At, B1); PG8_BAR; PG8_SCHED;
            } else {
            PG8_LDB(B0, 0, 0); PG8_SCHED; PG8_LDA(At, 0, 0); PG8_STAGE(PG8_SA(1, 1), a1 + hstep, voffA);
            PG8_WAIT_L(8); PG8_BAR; PG8_WAIT_L(0); PG8_MMA(0, 0, At, B0); PG8_BAR; PG8_SCHED;
            PG8_LDB(B1, 0, 1); PG8_STAGE(PG8_SB(0, 0), b2, voffB);
            PG8_BAR; PG8_WAIT_L(0); PG8_MMA(0, 1, At, B1); PG8_BAR;
            PG8_LDA(At, 0, 1); PG8_STAGE(PG8_SA(0, 0), a2, voffA);
            PG8_BAR; PG8_WAIT_L(0); PG8_MMA(1, 0, At, B0); PG8_BAR; PG8_SCHED;
            PG8_STAGE(PG8_SB(0, 1), b2 + hstep, voffB);
            PG8_WAIT_V(6); PG8_BAR; PG8_MMA(1, 1, At, B1); PG8_BAR;
            PG8_LDB(B0, 1, 0); PG8_SCHED; PG8_LDA(At, 1, 0); PG8_STAGE(PG8_SA(0, 1), a2 + hstep, voffA);
            PG8_WAIT_L(8); PG8_BAR; PG8_WAIT_L(0); PG8_MMA(0, 0, At, B0); PG8_BAR; PG8_SCHED;
            PG8_LDB(B1, 1, 1); PG8_STAGE(PG8_SB(1, 0), b3, voffB);
            PG8_BAR; PG8_WAIT_L(0); PG8_MMA(0, 1, At, B1); PG8_BAR;
            PG8_LDA(At, 1, 1); PG8_STAGE(PG8_SA(1, 0), a3, voffA);
            PG8_BAR; PG8_WAIT_L(0); PG8_MMA(1, 0, At, B0); PG8_BAR; PG8_SCHED;
            PG8_STAGE(PG8_SB(1, 1), b3 + hstep, voffB);
            PG8_WAIT_V(6); PG8_BAR; PG8_MMA(1, 1, At, B1); PG8_BAR;
            }
        }
        if constexpr (ALIGN_EPI) { if (wr == 0) PG8_BAR; }
        if constexpr (!Epi::AFTER_DRAIN) { E(acc, cur, wr, wc, fr, fq); S.done(cur); }
        if (!has_next) break;
#pragma unroll
        for (int a = 0; a < 2; ++a)
#pragma unroll
            for (int b = 0; b < 2; ++b)
#pragma unroll
                for (int m = 0; m < 4; ++m)
#pragma unroll
                    for (int n = 0; n < 2; ++n) acc[a][b][m][n] = (f32x4){0.f, 0.f, 0.f, 0.f};
        cur = nxt; cA = nA; cB = nB; ++ui;
        if constexpr (ALIGN_EPI) { if (wr == 1) PG8_BAR; }
    }
    PG8_WAIT_V(0);
    if constexpr (!ALIGN_EPI) { if (wr == 0) PG8_BAR; }
    PG8_BAR;
    if constexpr (Epi::AFTER_DRAIN) { E.fused(acc, cur, wr, wc, fr, fq, lds, wid, lane); S.done(cur); }
#undef PG8_SA
#undef PG8_SB
#undef PG8_STAGE
#undef PG8_LDA
#undef PG8_LDB
#undef PG8_MMA
#undef PG8_WAIT_V
#undef PG8_WAIT_L
#undef PG8_BAR
#undef PG8_SCHED
}
}

#ifndef PG8_SP2
#define PG8_SP2 true
#endif
#ifndef PG8_ALIGN
#define PG8_ALIGN true
#endif
constexpr int RING_OFF = 0, RING_BYTES = 131072;
constexpr int LDSCTL_OFF = RING_BYTES, MISC_OFF = LDSCTL_OFF + 320;
constexpr int LDS_BYTES = 147456;

typedef GAS unsigned gu32;
#define RLX_AGENT __ATOMIC_RELAXED, __HIP_MEMORY_SCOPE_AGENT
#define LDS_WAIT() asm volatile("s_waitcnt lgkmcnt(0)" ::: "memory")
#define VM_WAIT() asm volatile("s_waitcnt vmcnt(0)" ::: "memory")
constexpr int CW_BAR = 4096;
#define XB_TMO      128
#define XB_XCNT(j)  (256  + 64 * (j))
#define XB_XSUB(j)  (1280 + 64 * (j))
#define XB_XGEN(j)  (2304 + 64 * (j))
#define XB_TOP      3328
#define XB_TOPGEN   3392
#define XCD_BAR_WORDS 3456
#define XB_SPIN_CAP (1u << 18)

__device__ __forceinline__ unsigned xb_ld(unsigned* p)              { return __hip_atomic_load(p, __ATOMIC_RELAXED, __HIP_MEMORY_SCOPE_AGENT); }
__device__ __forceinline__ unsigned xb_add(unsigned* p, unsigned v) { return __hip_atomic_fetch_add(p, v, __ATOMIC_RELAXED, __HIP_MEMORY_SCOPE_AGENT); }
__device__ __forceinline__ unsigned xb_xcc_id() { return (unsigned)__builtin_amdgcn_s_getreg((3 << 11) | 20) & 0xFu; }
#define XB_SPIN(cond, bar) do { unsigned _sp = 0; while (cond) { __builtin_amdgcn_s_sleep(1); \
    if ((++_sp & 255u) == 0u) { if (xb_ld(&(bar)[XB_TMO])) break; if (_sp > XB_SPIN_CAP) { atomicAdd(&(bar)[XB_TMO], 1u); break; } } } } while (0)

struct XcdBarrier {
    unsigned* bar; unsigned x;
    volatile LAS unsigned* st;
};

__device__ __forceinline__ XcdBarrier xcd_barrier_post(unsigned* bar, volatile LAS unsigned* st) {
    XcdBarrier b; b.bar = bar; b.x = xb_xcc_id(); b.st = st;
    if (threadIdx.x == 0) (void)xb_add(&bar[XB_XCNT(b.x)], 1u);
    return b;
}
__device__ __forceinline__ void xcd_barrier_complete(unsigned* bar, unsigned x, unsigned& nloc, unsigned& nx) {
    const unsigned G = gridDim.x * gridDim.y * gridDim.z;
    unsigned sum, cnt, mine, sp = 0u;
    for (;;) {
        sum = 0u; cnt = 0u; mine = 0u;
#pragma unroll
        for (unsigned j = 0; j < 16; ++j) { const unsigned c = xb_ld(&bar[XB_XCNT(j)]); sum += c; cnt += (c > 0u) ? 1u : 0u; mine = (j == x) ? c : mine; }
        if (sum == G) break;
        __builtin_amdgcn_s_sleep(1);
        if ((++sp & 255u) == 0u) { if (xb_ld(&bar[XB_TMO])) break; if (sp > XB_SPIN_CAP) { atomicAdd(&bar[XB_TMO], 1u); break; } }
    }
    nloc = mine > 0u ? mine : 1u; nx = cnt > 0u ? cnt : 1u;
}

__device__ __forceinline__ void xcd_barrier(const XcdBarrier& b) {
    asm volatile("s_waitcnt vmcnt(0)" ::: "memory");
    __syncthreads();
    if (threadIdx.x == 0) {
        unsigned* bar = b.bar;
        __builtin_amdgcn_s_waitcnt(0);
        unsigned nloc = b.st[0], nx = b.st[1];
        if (nloc == 0u) { xcd_barrier_complete(bar, b.x, nloc, nx); b.st[0] = nloc; b.st[1] = nx; }
        const unsigned old = xb_add(&bar[XB_XSUB(b.x)], 1u);
        const unsigned gen = old / nloc;
        if (old + 1u == (gen + 1u) * nloc) {
            __builtin_amdgcn_fence(__ATOMIC_RELEASE, "agent");
            asm volatile("s_waitcnt vmcnt(0)" ::: "memory");
            const unsigned og = xb_add(&bar[XB_TOP], 1u);
            const unsigned tg = og / nx;
            if (og + 1u == (tg + 1u) * nx) xb_add(&bar[XB_TOPGEN], 1u);
            else XB_SPIN(xb_ld(&bar[XB_TOPGEN]) == tg, bar);
            __builtin_amdgcn_fence(__ATOMIC_ACQUIRE, "agent");
            xb_add(&bar[XB_XGEN(b.x)], 1u);
            asm volatile("s_waitcnt vmcnt(0)" ::: "memory");
        } else {
            XB_SPIN(xb_ld(&bar[XB_XGEN(b.x)]) == gen, bar);
            __builtin_amdgcn_fence(__ATOMIC_ACQUIRE, "agent");
            asm volatile("s_waitcnt vmcnt(0)" ::: "memory");
        }
    }
    __syncthreads();
}

typedef __attribute__((address_space(4))) const unsigned long long* kargp_t;
struct Frame {
    LAS unsigned char* lds;
    int tid, lane, wave, G, gw, ngw;
    unsigned char* ws;
    kargp_t kp; int cu;
};
__device__ __forceinline__ kargp_t kargs() {
    const unsigned long long v = (unsigned long long)__builtin_amdgcn_kernarg_segment_ptr(); unsigned lo = (unsigned)v, hi = (unsigned)(v >> 32);
    asm volatile("" : "+s"(lo), "+s"(hi)); return (kargp_t)(((unsigned long long)hi << 32) | lo);
}
__device__ __forceinline__ void relaunder(Frame& F) {
    int t = threadIdx.x; asm volatile("" : "+v"(t));
    int bx = __builtin_amdgcn_readfirstlane((int)blockIdx.x); asm volatile("" : "+s"(bx));
    F.kp = kargs(); F.ws = (unsigned char*)(GAS unsigned char*)F.kp[26]; F.cu = bx;
    F.tid = t; F.lane = t & 63; F.wave = __builtin_amdgcn_readfirstlane(t >> 6); F.gw = bx * NWAVES + F.wave;
}
__device__ __forceinline__ float wave_sum(float v) {
#pragma unroll
    for (int o = 1; o < 64; o <<= 1) v += __shfl_xor(v, o);
    return v;
}
__device__ __forceinline__ float bf2f(unsigned short x) { return __uint_as_float((unsigned)x << 16); }
__device__ __forceinline__ float bflo(unsigned x) { return __uint_as_float(x << 16); }
__device__ __forceinline__ float bfhi(unsigned x) { return __uint_as_float(x & 0xffff0000u); }
using pg8::cvt_pk_bf16;
using pg8::sigmoid_fast;

enum { I_X = 0, I_C, I_CTX, I_CCTX, I_MODW, I_MODB, I_LNMG, I_LNMB, I_LNFG, I_LNFB, I_WG, I_WU, I_WDN, I_WIN, I_CONVW, I_CONVB, I_GAW, I_GAB, I_GXW, I_GXB, I_LAM, I_WOUT, I_WQKV, I_SINK, I_WO };

__device__ __forceinline__ void p0_transpose_item(const float* W, int K, int N, bf16_t* WT, int k0, int n0, int drow0, LAS float* scr, int lane) {
#pragma unroll 8
    for (int i = 0; i < 32; ++i) { const int kk = 2 * i + (lane >> 5); scr[kk * 33 + (lane & 31)] = W[(size_t)(k0 + kk) * N + n0 + (lane & 31)]; }
    LDS_WAIT(); asm volatile("" ::: "memory");
    const int c = lane & 7;
#pragma unroll
    for (int j = 0; j < 4; ++j) { const int n = (lane >> 3) + 8 * j; const LAS float* s = scr + (8 * c) * 33 + n;
        u32x4 o; o.x = cvt_pk_bf16(s[0 * 33], s[1 * 33]); o.y = cvt_pk_bf16(s[2 * 33], s[3 * 33]); o.z = cvt_pk_bf16(s[4 * 33], s[5 * 33]); o.w = cvt_pk_bf16(s[6 * 33], s[7 * 33]);
        *(GAS u32x4*)(WT + (size_t)(drow0 + n) * K + k0 + 8 * c) = o; }
    LDS_WAIT(); asm volatile("" ::: "memory");
}
__device__ __forceinline__ float silu_acc(float x) { return x / (1.f + expf(-x)); }
constexpr int CV_IT_FFN = (D / 64) * (FF / 32), CV_IT_WIN = CV_IT_FFN, CV_IT_WOUT = (DR / 64) * (D / 32), CV_IT_QKV = (D / 64) * (NQKV / 32), CV_IT_WO = (D / 64) * (D / 32);
constexpr int CV_N_FFN = DEPTH * 3 * CV_IT_FFN, CV_N_REC = 2 * (CV_IT_WIN + CV_IT_WOUT), CV_N_ATT = 2 * (CV_IT_QKV + CV_IT_WO), CV_NITEMS = CV_N_FFN + CV_N_REC + CV_N_ATT;
struct CvDesc { const float* W; bf16_t* WT; int K, N, nblk, map; };
__device__ __forceinline__ int cv_drow(int map, int n0) {
    if (map == 1) return (n0 >> 7) * 256 + (n0 & 127);
    if (map == 2) return (n0 >> 7) * 256 + 128 + (n0 & 127);
    if (map == 3 && n0 < NQK) { const int pn = n0 >> 8, rem = n0 & 255, hd = rem >> 7, d = rem & 127; return pn * 256 + (d >> 6) * 128 + hd * 64 + (d & 63); }
    return n0;
}
__device__ __forceinline__ void cv_matrix(Frame& F, int it, CvDesc& d, int& q) {
    int r = it;
    if (r < CV_N_FFN) { const int L = r / (3 * CV_IT_FFN), w = (r / CV_IT_FFN) % 3; q = r % CV_IT_FFN;
        if (w < 2) { d.W = ((const float*)(GAS const float*)F.kp[w == 0 ? I_WG : I_WU]) + (size_t)L * D * FF; d.WT = (bf16_t*)(F.ws + WS_WGU) + (size_t)L * (2 * FF) * D; d.K = D; d.N = FF; d.nblk = FF / 32; d.map = 1 + w; }
        else { d.W = ((const float*)(GAS const float*)F.kp[I_WDN]) + (size_t)L * FF * D; d.WT = (bf16_t*)(F.ws + WS_WD) + (size_t)L * D * FF; d.K = FF; d.N = D; d.nblk = D / 32; d.map = 0; }
        return; }
    r -= CV_N_FFN;
    if (r < CV_N_REC) { const int j = r / (CV_IT_WIN + CV_IT_WOUT); q = r % (CV_IT_WIN + CV_IT_WOUT);
        if (q < CV_IT_WIN) { d.W = ((const float*)(GAS const float*)F.kp[I_WIN]) + (size_t)j * D * FF; d.WT = (bf16_t*)(F.ws + WS_WIN) + (size_t)j * FF * D; d.K = D; d.N = FF; d.nblk = FF / 32; d.map = 0; }
        else { q -= CV_IT_WIN; d.W = ((const float*)(GAS const float*)F.kp[I_WOUT]) + (size_t)j * DR * D; d.WT = (bf16_t*)(F.ws + WS_WOUT) + (size_t)j * D * DR; d.K = DR; d.N = D; d.nblk = D / 32; d.map = 0; }
        return; }
    r -= CV_N_REC;
    { const int j = r / (CV_IT_QKV + CV_IT_WO); q = r % (CV_IT_QKV + CV_IT_WO);
        if (q < CV_IT_QKV) { d.W = ((const float*)(GAS const float*)F.kp[I_WQKV]) + (size_t)j * D * NQKV; d.WT = (bf16_t*)(F.ws + WS_WQKV) + (size_t)j * NQKV * D; d.K = D; d.N = NQKV; d.nblk = NQKV / 32; d.map = 3; }
        else { q -= CV_IT_QKV; d.W = ((const float*)(GAS const float*)F.kp[I_WO]) + (size_t)j * D * D; d.WT = (bf16_t*)(F.ws + WS_WO) + (size_t)j * D * D; d.K = D; d.N = D; d.nblk = D / 32; d.map = 0; } }
}


__device__ __forceinline__ void phase_p0a(Frame& F) {
    relaunder(F);
    const int bx = F.cu;
    if (bx < DEPTH * (MODN / 256)) {
        const int L = bx / (MODN / 256), nb = bx % (MODN / 256);
        LAS float* sl = (LAS float*)(F.lds);
        LAS float* red = (LAS float*)(F.lds + 5 * D * 4);
        const float* c = ((const float*)(GAS const float*)F.kp[I_C]); const float* cc = ((const float*)(GAS const float*)F.kp[I_CCTX]);
        for (int i = F.tid; i < 5 * D; i += NWAVES * 64) { const int r = i / D, k = i % D; sl[i] = silu_acc(r < 4 ? c[r * D + k] : cc[k]); }
        __syncthreads();
        const float* W = ((const float*)(GAS const float*)F.kp[I_MODW]) + ((size_t)L * D + F.wave * 256) * MODN + nb * 256 + F.lane * 4;
        f32x4 a0 = {0.f, 0.f, 0.f, 0.f}, a1 = a0, a2 = a0, a3 = a0, a4 = a0;
        const LAS float* s0 = sl + F.wave * 256;
#pragma unroll 8
        for (int k = 0; k < 256; ++k) { const f32x4 w = *(const f32x4*)(W + (size_t)k * MODN);
            a0 += w * s0[k]; a1 += w * s0[D + k]; a2 += w * s0[2 * D + k]; a3 += w * s0[3 * D + k]; a4 += w * s0[4 * D + k]; }
        LAS f32x4* rw = (LAS f32x4*)(red + F.wave * 5 * 256) + F.lane;
        rw[0] = a0; rw[64] = a1; rw[128] = a2; rw[192] = a3; rw[256] = a4;
        __syncthreads();
        float* modv = (float*)(F.ws + WS_MODV);
        for (int o = F.tid; o < 5 * 256; o += NWAVES * 64) { const int r = o >> 8, n = o & 255; float s = 0.f;
#pragma unroll
            for (int w = 0; w < 8; ++w) s += red[w * 5 * 256 + r * 256 + n];
            modv[((size_t)L * 5 + r) * MODN + nb * 256 + n] = s + ((const float*)(GAS const float*)F.kp[I_MODB])[(size_t)L * MODN + nb * 256 + n]; }
        __syncthreads();
    } else if (bx == 255) {
        f32x2* tab = (f32x2*)(F.ws + WS_ROPE);
        for (int i = F.tid; i < 64 * 32; i += NWAVES * 64) { const int pos = i >> 5, f = i & 31; const float inv = powf(10000.f, -(float)(2 * f) / 64.f); const float ang = (float)pos * inv;
            tab[i] = (f32x2){cosf(ang), sinf(ang)}; }
    }
    LAS float* scr = (LAS float*)(F.lds + F.wave * 8448);
    for (int it = CV_N_FFN + F.gw; it < CV_N_FFN + CV_IT_WIN; it += F.ngw) {
        CvDesc d; int q; cv_matrix(F, it, d, q);
        const int kb = q / d.nblk, nb = q % d.nblk;
        p0_transpose_item(d.W, d.K, d.N, d.WT, kb * 64, nb * 32, cv_drow(d.map, nb * 32), scr, F.lane);
    }
}

template <int MODE>
__device__ __forceinline__ void phase_rows(Frame& F, int nrows, const float* gam, const float* bet, const float* modS, int off_sh, int off_sc, const float* slab = nullptr, const float* gslab = nullptr) {
    relaunder(F);
    float* HA = (float*)(F.ws + WS_HA); bf16_t* U = (bf16_t*)(F.ws + WS_U);
    for (int row = F.gw; row < nrows; row += F.ngw) {
        const int r = row < ML ? (row >> 12) : 4;
        f32x4 v[8];
        if (MODE == 0) { const float* src = row < ML ? ((const float*)(GAS const float*)F.kp[I_X]) + (size_t)row * D : ((const float*)(GAS const float*)F.kp[I_CTX]) + (size_t)(row - ML) * D;
#pragma unroll
            for (int j = 0; j < 8; ++j) v[j] = *(const f32x4*)(src + 4 * F.lane + 256 * j);
        } else {
            float s = 0.f;
#pragma unroll
            for (int j = 0; j < 8; ++j) v[j] = *(const f32x4*)(HA + (size_t)row * D + 4 * F.lane + 256 * j);
            if (slab != nullptr && row >= ML) {
#pragma unroll
                for (int j = 0; j < 8; ++j) { const int c = 4 * F.lane + 256 * j; f32x4 ps = {0.f, 0.f, 0.f, 0.f};
#pragma unroll
                    for (int q = 0; q < 8; ++q) ps += *(const f32x4*)(slab + ((size_t)q * MC + (row - ML)) * D + c);
                    v[j] += *(const f32x4*)(gslab + c) * ps; } }
#pragma unroll
            for (int j = 0; j < 8; ++j) s += (v[j][0] + v[j][1]) + (v[j][2] + v[j][3]);
            const float mean = wave_sum(s) * (1.f / D); float q = 0.f;
#pragma unroll
            for (int j = 0; j < 8; ++j) { v[j] = v[j] - mean; q += (v[j][0] * v[j][0] + v[j][1] * v[j][1]) + (v[j][2] * v[j][2] + v[j][3] * v[j][3]); }
            const float rstd = 1.f / sqrtf(wave_sum(q) * (1.f / D) + LN_EPS);
            if (MODE == 1 && F.lane == 0) *(f32x2*)((float*)(F.ws + WS_STATS) + 2 * (size_t)row) = (f32x2){mean, rstd};
#pragma unroll
            for (int j = 0; j < 8; ++j) { const f32x4 g = *(const f32x4*)(gam + 4 * F.lane + 256 * j), b = *(const f32x4*)(bet + 4 * F.lane + 256 * j); v[j] = v[j] * rstd * g + b; }
        }
        if (MODE == 2) {
#pragma unroll
            for (int j = 0; j < 8; ++j) *(f32x4*)(((float*)(GAS float*)F.kp[25]) + (size_t)row * D + 4 * F.lane + 256 * j) = v[j];
        } else {
            const float* ms = modS + (size_t)r * MODN;
#pragma unroll
            for (int j = 0; j < 8; ++j) { const int c = 4 * F.lane + 256 * j;
                if (row >= ML) *(f32x4*)(HA + (size_t)row * D + c) = v[j] * ALPHA;
                const f32x4 sc = *(const f32x4*)(ms + off_sc + c), sh = *(const f32x4*)(ms + off_sh + c); const f32x4 u = v[j] * (sc + 1.0f) + sh;
                u32x2 w; w.x = cvt_pk_bf16(u[0], u[1]); w.y = cvt_pk_bf16(u[2], u[3]); *(u32x2*)(U + (size_t)row * D + c) = w; }
        }
    }
}

__device__ __forceinline__ void phase_conv(Frame& F, int j) {
    relaunder(F);
    const bf16_t* P = (const bf16_t*)(F.ws + WS_BIG); bf16_t* Z = (bf16_t*)(F.ws + WS_Z);
    const float* cw = ((const float*)(GAS const float*)F.kp[I_CONVW]) + (size_t)j * 4 * DR; const float* cb = ((const float*)(GAS const float*)F.kp[I_CONVB]) + (size_t)j * DR;
    constexpr int RCH = 16, NITEMS = (MT / RCH) * 6;
    for (int it = F.gw; it < NITEMS; it += F.ngw) {
        const int rc = it / 6, cbk = it % 6, row0 = rc * RCH;
        const int pc0 = cbk * 512 + F.lane * 8, hb = pc0 / 192, i0 = pc0 % 192; const bool valid = i0 < BW; const int ch = hb * BW + i0;
        const int seq_lo = row0 < ML ? (row0 & ~(SEQ - 1)) : (ML + ((row0 - ML) & ~(CTXL - 1))), seq_hi = seq_lo + (row0 < ML ? SEQ : CTXL);
        const int chc = valid ? ch : hb * BW;
        float w[4][8], bias[8];
        { const f32x4 b0 = *(const f32x4*)(cb + chc), b1 = *(const f32x4*)(cb + chc + 4);
#pragma unroll
          for (int e = 0; e < 4; ++e) { bias[e] = valid ? b0[e] : 0.f; bias[4 + e] = valid ? b1[e] : 0.f; }
#pragma unroll
          for (int t = 0; t < 4; ++t) { const f32x4 w0 = *(const f32x4*)(cw + t * DR + chc), w1 = *(const f32x4*)(cw + t * DR + chc + 4);
#pragma unroll
              for (int e = 0; e < 4; ++e) { w[t][e] = valid ? w0[e] : 0.f; w[t][4 + e] = valid ? w1[e] : 0.f; } } }
        const bf16_t* src = P + DR + chc;
#define ld(rw) ([&]() -> u32x4 { const int rw_ = (rw); const int rc_ = rw_ < seq_lo ? seq_lo : (rw_ >= seq_hi ? seq_hi - 1 : rw_); u32x4 z_ = *(const u32x4*)(src + (size_t)rc_ * FF); \
        const bool in_ = rw_ >= seq_lo && rw_ < seq_hi; z_.x = in_ ? z_.x : 0u; z_.y = in_ ? z_.y : 0u; z_.z = in_ ? z_.z : 0u; z_.w = in_ ? z_.w : 0u; return z_; }())
        u32x4 xr[RCH + 3];
#pragma unroll
        for (int i = 0; i < RCH + 3; ++i) xr[i] = ld(row0 - 2 + i);
#pragma unroll
        for (int i = 0; i < RCH; ++i) {
            const int row = row0 + i; const u32x4 xm2 = xr[i], xm1 = xr[i + 1], x0 = xr[i + 2], xp1 = xr[i + 3];
            float o[8];
#pragma unroll
            for (int e = 0; e < 8; ++e) { const int wd = e >> 1; const bool hi = e & 1;
                const float a = hi ? bfhi(xm2[wd]) : bflo(xm2[wd]), b = hi ? bfhi(xm1[wd]) : bflo(xm1[wd]), c = hi ? bfhi(x0[wd]) : bflo(x0[wd]), d = hi ? bfhi(xp1[wd]) : bflo(xp1[wd]);
                o[e] = bias[e] + w[0][e] * a + w[1][e] * b + w[2][e] * c + w[3][e] * d; }
            u32x4 ov; ov.x = cvt_pk_bf16(o[0], o[1]); ov.y = cvt_pk_bf16(o[2], o[3]); ov.z = cvt_pk_bf16(o[4], o[5]); ov.w = cvt_pk_bf16(o[6], o[7]);
            {
                const int bb = row < ML ? (row >> 12) : ((row - ML) >> 8), tl = row < ML ? (16 + ((row & (SEQ - 1)) >> 4)) : (((row - ML) & (CTXL - 1)) >> 4);
                const size_t zo = ((((size_t)(bb * 16 + hb) * 272 + tl) * 6 + (i0 >> 5)) * 64 + ((i0 & 31) >> 3) * 16 + (row & 15)) * 8;
                *(u32x4*)(Z + zo) = ov; }
        }
#undef ld
    }
}

template <int CTRL> __device__ __forceinline__ float dpp_f(float old, float v) {
    return __builtin_bit_cast(float, __builtin_amdgcn_update_dpp(__builtin_bit_cast(int, old), __builtin_bit_cast(int, v), CTRL, 0xf, 0xf, false));
}
template <int REV> __device__ __forceinline__ void row_scan(float& P, float& H) {
#define RS_STEP(C) { const float hs = dpp_f<C>(0.f, H), ps = dpp_f<C>(1.f, P); H = fmaf(P, hs, H); P = P * ps; }
    if (REV == 0) { RS_STEP(0x111) RS_STEP(0x112) RS_STEP(0x114) RS_STEP(0x118) }
    else          { RS_STEP(0x101) RS_STEP(0x102) RS_STEP(0x104) RS_STEP(0x108) }
#undef RS_STEP
}
template <int REV> __device__ __forceinline__ void row_scan4(f32x4& P, f32x4& H) {
    float p0 = P[0], p1 = P[1], p2 = P[2], p3 = P[3], h0 = H[0], h1 = H[1], h2 = H[2], h3 = H[3];
#define RS4(SH) asm volatile("s_nop 1\n\t" \
        "v_fmac_f32_dpp %0, %0, %4 " SH " row_mask:0xf bank_mask:0xf\n\tv_fmac_f32_dpp %1, %1, %5 " SH " row_mask:0xf bank_mask:0xf\n\t" \
        "v_fmac_f32_dpp %2, %2, %6 " SH " row_mask:0xf bank_mask:0xf\n\tv_fmac_f32_dpp %3, %3, %7 " SH " row_mask:0xf bank_mask:0xf\n\t" \
        "v_mul_f32_dpp %4, %4, %4 " SH " row_mask:0xf bank_mask:0xf\n\tv_mul_f32_dpp %5, %5, %5 " SH " row_mask:0xf bank_mask:0xf\n\t" \
        "v_mul_f32_dpp %6, %6, %6 " SH " row_mask:0xf bank_mask:0xf\n\tv_mul_f32_dpp %7, %7, %7 " SH " row_mask:0xf bank_mask:0xf" \
        : "+v"(h0), "+v"(h1), "+v"(h2), "+v"(h3), "+v"(p0), "+v"(p1), "+v"(p2), "+v"(p3))
    if (REV == 0) { RS4("row_shr:1"); RS4("row_shr:2"); RS4("row_shr:4"); RS4("row_shr:8"); }
    else          { RS4("row_shl:1"); RS4("row_shl:2"); RS4("row_shl:4"); RS4("row_shl:8"); }
#undef RS4
    P = (f32x4){p0, p1, p2, p3}; H = (f32x4){h0, h1, h2, h3};
}
typedef int i32x4 __attribute__((ext_vector_type(4)));
constexpr int RS_NS = 8, RS_PD = 5, RS_TILE_B = 6144, RS_RING = RS_NS * RS_TILE_B, RS_HS = 4, RS_HD = 3;
template <int DIR, bool ACTIVE>
__device__ __forceinline__ void rec_sweep(Frame& F, int j, int b, int hb, int ct, int k) {
    const int lane = F.lane, fr = lane & 15, fq = lane >> 4;
    const __amdgpu_buffer_rsrc_t rW = __builtin_amdgcn_make_buffer_rsrc((void*)F.ws, 0, (int)WS_END, 0x00020000);
    const int voH = (fr * 16 + 4 * fq) * 2, voP = (fr * FF + 4 * fq) * 2, voV = (fr * DR + 4 * fq) * 2;
    const int sTrash = (int)(WS_HF + (size_t)MT * DR * 2 + 65536) + F.gw * 2048;
    LAS unsigned char* ring = F.lds + DIR * RS_RING;
    const int zso = (int)WS_Z + (b * 16 + hb) * 272 * RS_TILE_B + (2 * k) * 1024, zlo = lane * 16;
    const size_t wbase = ((size_t)(j * 2 + DIR) * 16 + hb) * BW * BW;
    const float* Wa = ((const float*)(GAS const float*)F.kp[I_GAW]) + wbase; const float* Wx = ((const float*)(GAS const float*)F.kp[I_GXW]) + wbase;
    bf16x8 Af[2][6];
    const int oc = ct * 16 + fr;
#pragma unroll
    for (int ks = 0; ks < 6; ++ks) { float va[8], vx[8];
#pragma unroll
        for (int jj = 0; jj < 8; ++jj) { const int i = ks * 32 + 8 * fq + jj; const bool ok = i < BW; va[jj] = ok ? Wa[(size_t)i * BW + oc] : 0.f; vx[jj] = ok ? Wx[(size_t)i * BW + oc] : 0.f; }
        u32x4 pa, px; pa.x = cvt_pk_bf16(va[0], va[1]); pa.y = cvt_pk_bf16(va[2], va[3]); pa.z = cvt_pk_bf16(va[4], va[5]); pa.w = cvt_pk_bf16(va[6], va[7]);
        px.x = cvt_pk_bf16(vx[0], vx[1]); px.y = cvt_pk_bf16(vx[2], vx[3]); px.z = cvt_pk_bf16(vx[4], vx[5]); px.w = cvt_pk_bf16(vx[6], vx[7]);
        Af[0][ks] = __builtin_bit_cast(bf16x8, pa); Af[1][ks] = __builtin_bit_cast(bf16x8, px); }
    const int cg = hb * BW + ct * 16 + 4 * fq; const size_t pv = (size_t)(j * 2 + DIR) * DR + cg;
    const f32x4 ba = *(const f32x4*)(((const float*)(GAS const float*)F.kp[I_GAB]) + pv) * (-LOG2E), bx = *(const f32x4*)(((const float*)(GAS const float*)F.kp[I_GXB]) + pv) * (-LOG2E), lam = *(const f32x4*)(((const float*)(GAS const float*)F.kp[I_LAM]) + pv);
    f32x4 c1;
#pragma unroll
    for (int e = 0; e < 4; ++e) c1[e] = -8.0f * LOG2E * log1pf(expf(-lam[e]));
    f32x4 hst = {0.f, 0.f, 0.f, 0.f};
    const int hfs = (hb * 11 + ct) * (MT * 16), cgs = hb * BW + ct * 16;
    const int zzo = (ct >> 1) * 1024 + ((2 * (ct & 1) + (fq >> 1)) * 16 + fr) * 16 + (fq & 1) * 8;
#define RS_ROW0(s) (DIR == 0 ? ((s) < 16 ? (ML + b * CTXL + 16 * (s)) : (b * SEQ + 16 * ((s) - 16))) : ((s) < 16 ? (ML + b * CTXL + 16 * (15 - (s))) : (b * SEQ + 16 * (255 - ((s) - 16)))))
#define RS_TL(s) (DIR == 0 ? (s) : ((s) < 16 ? 15 - (s) : 287 - (s)))
#define RS_COMBINE(s) (((s) >= 8 && (s) < 16) || (s) >= 144)
#define RS_DMA(s) do { const int st_ = (s) < 272 ? (s) : 271; const int so_ = zso + RS_TL(st_) * RS_TILE_B; LAS unsigned char* l_ = ring + (st_ & (RS_NS - 1)) * RS_TILE_B + (2 * k) * 1024; \
        __builtin_amdgcn_raw_ptr_buffer_load_lds(rW, (LAS unsigned*)l_, 16, zlo, so_, 0, 0); __builtin_amdgcn_raw_ptr_buffer_load_lds(rW, (LAS unsigned*)(l_ + 1024), 16, zlo, so_ + 1024, 0, 0); } while (0)
    LAS unsigned char* hyr = F.lds + 2 * RS_RING + F.wave * 4096;
    const int voY = ((lane >> 3) * FF) * 2 + (lane & 7) * 4, voH4 = lane * 4;
#define RS_LOADS(s, REAL) do { const int st_ = (s) < 272 ? (s) : 271; const bool cmb_ = (REAL) ? true : ((st_ >= 11 && st_ < 16) || st_ >= 147); \
        const int sy_ = (int)WS_BIG + (RS_ROW0(st_) * FF + cgs) * 2; \
        const int sh_ = cmb_ ? (int)WS_HF + (hfs + RS_ROW0(st_) * 16) * 2 : sy_; const int sh2_ = cmb_ ? 256 : 8 * FF * 2; const int ho_ = cmb_ ? voH4 : voY; \
        LAS unsigned char* l_ = hyr + (st_ & (RS_HS - 1)) * 1024; \
        __builtin_amdgcn_raw_ptr_buffer_load_lds(rW, (LAS unsigned*)l_, 4, ho_, sh_, 0, 0); __builtin_amdgcn_raw_ptr_buffer_load_lds(rW, (LAS unsigned*)(l_ + 256), 4, ho_, sh_ + sh2_, 0, 0); \
        __builtin_amdgcn_raw_ptr_buffer_load_lds(rW, (LAS unsigned*)(l_ + 512), 4, voY, sy_, 0, 0); __builtin_amdgcn_raw_ptr_buffer_load_lds(rW, (LAS unsigned*)(l_ + 768), 4, voY, sy_ + 8 * FF * 2, 0, 0); } while (0)
#define RS_MMA(s, aa_, ax_) do { if (ACTIVE) { const LAS unsigned char* tb_ = ring + ((s) & (RS_NS - 1)) * RS_TILE_B; bf16x8 bfr[6]; \
        _Pragma("unroll") for (int ks = 0; ks < 6; ++ks) bfr[ks] = *(const LAS bf16x8*)(tb_ + ks * 1024 + lane * 16); \
        aa_ = (f32x4){0.f, 0.f, 0.f, 0.f}; ax_ = aa_; \
        _Pragma("unroll") for (int ks = 0; ks < 6; ++ks) { aa_ = __builtin_amdgcn_mfma_f32_16x16x32_bf16(Af[0][ks], bfr[ks], aa_, 0, 0, 0); ax_ = __builtin_amdgcn_mfma_f32_16x16x32_bf16(Af[1][ks], bfr[ks], ax_, 0, 0, 0); } } } while (0)
#define RS_EWA(s, aa_, ax_, P_, H_) do { if (ACTIVE) { const u32x2 zz_ = *(const LAS u32x2*)(ring + ((s) & (RS_NS - 1)) * RS_TILE_B + zzo); \
        const float zv[4] = {bflo(zz_[0]), bfhi(zz_[0]), bflo(zz_[1]), bfhi(zz_[1])}; \
        _Pragma("unroll") for (int e = 0; e < 4; ++e) { \
            const float rg = __builtin_amdgcn_rcpf(1.0f + __builtin_amdgcn_exp2f(fmaf(aa_[e], -LOG2E, ba[e]))), ig = __builtin_amdgcn_rcpf(1.0f + __builtin_amdgcn_exp2f(fmaf(ax_[e], -LOG2E, bx[e])));     \
            P_[e] = __builtin_amdgcn_exp2f(c1[e] * rg); \
            H_[e] = __builtin_amdgcn_sqrtf(fmaf(-P_[e], P_[e], 1.0f)) * ig * zv[e]; } } } while (0)
#define RS_STEP(s, aN_, xN_, aM_, xM_, PM_, HM_, PC_, HC_, FLIPCODE) do {     \
        if ((s) == 8 || (s) == 144) asm volatile("s_waitcnt vmcnt(0)" ::: "memory"); else asm volatile("s_waitcnt vmcnt(16)" ::: "memory"); \
        asm volatile("s_waitcnt lgkmcnt(0)" ::: "memory"); __builtin_amdgcn_s_barrier(); asm volatile("" ::: "memory"); \
        FLIPCODE; \
        RS_DMA((s) + RS_PD); \
        RS_MMA((s) + 2, aN_, xN_); \
        RS_EWA((s) + 1, aM_, xM_, PM_, HM_); \
        if (ACTIVE) { \
        const bool cmb = RS_COMBINE(s); f32x4 aa, hn; \
        const u32x2 hp_ = *(const LAS u32x2*)(hyr + ((s) & (RS_HS - 1)) * 1024 + fr * 32 + fq * 8), yy_ = *(const LAS u32x2*)(hyr + ((s) & (RS_HS - 1)) * 1024 + 512 + fr * 32 + fq * 8); \
        { f32x4 Pv4 = PC_, Hv4 = HC_; \
          row_scan4<DIR>(Pv4, Hv4); \
          _Pragma("unroll") for (int e = 0; e < 4; ++e) { \
            const float Hv = fmaf(Pv4[e], hst[e], Hv4[e]); \
            hn[e] = __shfl(Hv, (lane & 48) | (DIR == 0 ? 15 : 0)); \
            aa[e] = Hv; } } \
        hst = hn; \
        { u32x2 hw_; hw_.x = cvt_pk_bf16(aa[0], aa[1]); hw_.y = cvt_pk_bf16(aa[2], aa[3]); __builtin_amdgcn_raw_buffer_store_b64(hw_, rW, voH, cmb ? sTrash : (int)WS_HF + (hfs + RS_ROW0(s) * 16) * 2, 0); } \
        { const float yv[4] = {bflo(yy_[0]), bfhi(yy_[0]), bflo(yy_[1]), bfhi(yy_[1])}; \
            u32x2 o; o.x = cvt_pk_bf16(yv[0] * (aa[0] + bflo(hp_[0])), yv[1] * (aa[1] + bfhi(hp_[0]))); o.y = cvt_pk_bf16(yv[2] * (aa[2] + bflo(hp_[1])), yv[3] * (aa[3] + bfhi(hp_[1]))); \
            __builtin_amdgcn_raw_buffer_store_b64(o, rW, voV, cmb ? (int)WS_V + (RS_ROW0(s) * DR + cgs) * 2 : sTrash, 0); } \
        } else { const u32x2 z2_ = {0u, 0u}; __builtin_amdgcn_raw_buffer_store_b64(z2_, rW, voH, sTrash, 0); __builtin_amdgcn_raw_buffer_store_b64(z2_, rW, voV, sTrash, 0); } \
        RS_LOADS((s) + RS_HD, 0); } while (0)
    RS_DMA(0); RS_DMA(1); RS_DMA(2); RS_DMA(3); RS_DMA(4);
    RS_LOADS(0, 0); RS_LOADS(1, 0); RS_LOADS(2, 0);
    asm volatile("s_waitcnt vmcnt(0)" ::: "memory"); __builtin_amdgcn_s_barrier(); asm volatile("" ::: "memory");
    f32x4 aA = {0.f, 0.f, 0.f, 0.f}, xA = aA, aB = aA, xB = aA, PA = aA, HA_ = aA, PB = aA, HB = aA;
    RS_MMA(0, aA, xA); RS_MMA(1, aB, xB); RS_EWA(0, aA, xA, PA, HA_);
#define RS_FLIP(s) RS_LOADS(s, 1); RS_LOADS((s) + 1, 1); RS_LOADS((s) + 2, 1); asm volatile("s_waitcnt vmcnt(0)" ::: "memory")
#define RS_EVEN(s, FC) RS_STEP(s, aA, xA, aB, xB, PB, HB, PA, HA_, FC)
#define RS_ODD(s, FC)  RS_STEP(s, aB, xB, aA, xA, PA, HA_, PB, HB, FC)
    for (int s = 0; s < 8; s += 2) { RS_EVEN(s, ); RS_ODD(s + 1, ); }
    RS_EVEN(8, RS_FLIP(8)); RS_ODD(9, );
    for (int s = 10; s < 144; s += 2) { RS_EVEN(s, ); RS_ODD(s + 1, ); }
    RS_EVEN(144, RS_FLIP(144)); RS_ODD(145, );
    for (int s = 146; s < 272; s += 2) { RS_EVEN(s, ); RS_ODD(s + 1, ); }
#undef RS_FLIP
#undef RS_EVEN
#undef RS_ODD
#undef RS_MMA
#undef RS_EWA
#undef RS_ROW0
#undef RS_TL
#undef RS_COMBINE
#undef RS_DMA
#undef RS_LOADS
#undef RS_STEP
}
__device__ __forceinline__ void cv_piece(Frame& F, int j, int n, CvDesc& d, int& k0, int& n0, bool& valid) {
    const int len0 = 2 * 3 * CV_IT_FFN, st0 = j == 0 ? 0 : len0;
    const int len1 = j == 0 ? CV_IT_WOUT + CV_IT_WIN + CV_IT_WOUT : 0, st1 = CV_N_FFN + CV_IT_WIN;
    const int len2 = CV_IT_QKV + CV_IT_WO, st2 = CV_N_FFN + CV_N_REC + (j == 0 ? 0 : len2);
    const int total = 2 * (len0 + len1 + len2);
    const int cw = F.cu * 2 + (F.wave - 6); int vs = cw + 512 * n; valid = vs < total; if (!valid) vs = total - 1;
    const int v = vs >> 1, h = vs & 1; const int it = v < len0 ? st0 + v : (v < len0 + len1 ? st1 + (v - len0) : st2 + (v - len0 - len1));
    int q; cv_matrix(F, it, d, q); k0 = (q / d.nblk) * 64 + 32 * h; n0 = (q % d.nblk) * 32;
}
__device__ __forceinline__ void scan_convert(Frame& F, int j) {
    const int lane = F.lane;
    LAS float* scr = (LAS float*)(F.lds + 2 * RS_RING + 6 * 4096 + (F.wave - 6) * 4224);
    float lA[16], lB[16], lC[16];
    bf16_t* wA = nullptr; bf16_t* wB = nullptr; bf16_t* wC = nullptr; int kA = 0, kB = 0, kC = 0;
#define CV_LOAD(t, l_, w_out_, k_out_) do { CvDesc d_; int k0_, n0_; bool ok_; cv_piece(F, j, (t), d_, k0_, n0_, ok_); \
        const float* w_ = d_.W + (size_t)(k0_ + (lane >> 5)) * d_.N + n0_ + (lane & 31); \
        _Pragma("unroll") for (int i = 0; i < 16; ++i) l_[i] = w_[(size_t)(2 * i) * d_.N]; \
        w_out_ = ok_ ? d_.WT + (size_t)cv_drow(d_.map, n0_) * d_.K + k0_ : nullptr; k_out_ = d_.K; } while (0)
#define CV_USE(l_, w_in_, k_in_) do { \
        _Pragma("unroll") for (int i = 0; i < 16; ++i) scr[(2 * i + (lane >> 5)) * 33 + (lane & 31)] = l_[i]; \
        LDS_WAIT(); asm volatile("" ::: "memory"); \
        if (w_in_ != nullptr) { const int c_ = lane & 3; \
            _Pragma("unroll") for (int jj = 0; jj < 2; ++jj) { const int n_ = (lane >> 2) + 16 * jj; const LAS float* s_ = scr + (8 * c_) * 33 + n_; \
                u32x4 o_; o_.x = cvt_pk_bf16(s_[0 * 33], s_[1 * 33]); o_.y = cvt_pk_bf16(s_[2 * 33], s_[3 * 33]); o_.z = cvt_pk_bf16(s_[4 * 33], s_[5 * 33]); o_.w = cvt_pk_bf16(s_[6 * 33], s_[7 * 33]); \
                *(GAS u32x4*)(w_in_ + (size_t)n_ * k_in_ + 8 * c_) = o_; } } } while (0)
#define CV_BAR() do { asm volatile("s_waitcnt lgkmcnt(0)" ::: "memory"); __builtin_amdgcn_s_barrier(); asm volatile("" ::: "memory"); } while (0)
    const int npc = j == 0 ? 196 : 152, niter = (npc - 3 + 2) / 3 + 1;
    CV_LOAD(0, lA, wA, kA); CV_BAR(); CV_LOAD(1, lB, wB, kB); CV_BAR();
    for (int i = 0; i < niter; ++i) {
        const int t = 2 + 3 * i;
        CV_LOAD(t, lC, wC, kC);     CV_USE(lA, wA, kA); CV_BAR();
        CV_LOAD(t + 1, lA, wA, kA); CV_USE(lB, wB, kB); CV_BAR();
        CV_LOAD(t + 2, lB, wB, kB); CV_USE(lC, wC, kC); CV_BAR();
    }
    for (int t = 2 + 3 * niter; t < 273; ++t) CV_BAR();
#undef CV_LOAD
#undef CV_USE
#undef CV_BAR
}
__device__ __forceinline__ void phase_scan(Frame& F, int j) {
    relaunder(F);
    const int k = F.wave >> 1, dir = F.wave & 1;
    const int xcd = F.cu & 7, lc = F.cu >> 3, pr = xcd + 8 * (lc >> 2), g = lc & 3, ct = 3 * g + k;
    const int b = pr >> 4, hb = pr & 15;
    if (k < 3) {
        if (ct < 11) { if (dir == 0) rec_sweep<0, true>(F, j, b, hb, ct, k); else rec_sweep<1, true>(F, j, b, hb, ct, k); }
        else         { if (dir == 0) rec_sweep<0, false>(F, j, b, hb, 10, k); else rec_sweep<1, false>(F, j, b, hb, 10, k); }
    } else {
        scan_convert(F, j);
    }
}

constexpr int ATT_KB = 16384, ATT_BUF = 2 * ATT_KB, ATT_NB = 3;
__device__ __forceinline__ unsigned cvtpk_s(float lo, float hi) { return pg8::cvt_pk_bf16(lo, hi); }
__device__ __forceinline__ int crow(int r, int hi) { return (r & 3) + 8 * (r >> 2) + 4 * hi; }
__device__ __forceinline__ void attn_unit(Frame& F, int b, int kvh, int qrow0, bool is_ctx, int q0, const float* sink) {
    const bf16_t* QK = (const bf16_t*)(F.ws + WS_BIG); const bf16_t* VT = (const bf16_t*)(F.ws + WS_HF); bf16_t* ATT = (bf16_t*)(F.ws + WS_Z);
    const int tid = F.tid, lane = F.lane, wave = F.wave, r32 = lane & 31, hi = lane >> 5;
    const int head = kvh * 4 + (wave >> 1), qi = 32 * (wave & 1) + r32;
    const int qrow = qrow0 + qi;
    int jl = 0, nloc = 0;
    if (!is_ctx) { jl = q0 >= 128 ? 0 : (q0 >= 64 ? 1 : 2); const int jh = q0 <= SEQ - 192 ? 4 : (q0 <= SEQ - 128 ? 3 : 2); nloc = jh - jl + 1; }
    const int nt = nloc + 4;
#define ATT_DMA(t, buf) do { const int t_ = (t); int krow0_; if (t_ < nloc) krow0_ = b * SEQ + q0 - 128 + 64 * (jl + t_); else krow0_ = ML + b * CTXL + 64 * (t_ - nloc); \
        LAS unsigned char* kb_ = F.lds + (buf) * ATT_BUF; \
        _Pragma("unroll") for (int i_ = 0; i_ < 2; ++i_) { const int c_ = (2 * wave + i_) * 64 + lane; const int kr_ = c_ >> 4, kp_ = c_ & 15, vd_ = c_ >> 3, vp_ = c_ & 7; \
            __builtin_amdgcn_global_load_lds((const unsigned*)(QK + (size_t)(krow0_ + kr_) * NQK + 2048 + kvh * 128 + 8 * (kp_ ^ (kr_ & 15))), (LAS unsigned*)(kb_ + (2 * wave + i_) * 1024), 16, 0, 0); \
            __builtin_amdgcn_global_load_lds((const unsigned*)(VT + (size_t)(kvh * 128 + vd_) * MT + krow0_ + 8 * (vp_ ^ ((vd_ >> 1) & 7))), (LAS unsigned*)(kb_ + ATT_KB + (2 * wave + i_) * 1024), 16, 0, 0); } } while (0)
    bf16x8 qf[8];
#pragma unroll
    for (int ds = 0; ds < 8; ++ds) qf[ds] = *(const bf16x8*)(QK + (size_t)qrow * NQK + head * 128 + 16 * ds + 8 * hi);
    const float sk2 = sink[head] * LOG2E;
    float mrun = sk2, lrun = hi == 0 ? 1.0f : 0.0f;
    f32x16 o[4];
#pragma unroll
    for (int d = 0; d < 4; ++d)
#pragma unroll
        for (int r = 0; r < 16; ++r) o[d][r] = 0.f;
    ATT_DMA(0, 0); ATT_DMA(nt > 1 ? 1 : 0, 1);
    int bcur = 0, bnxt = 2;
    for (int t = 0; t < nt; ++t) {
        asm volatile("s_waitcnt vmcnt(4)" ::: "memory");
        asm volatile("s_waitcnt lgkmcnt(0)" ::: "memory"); __builtin_amdgcn_s_barrier(); asm volatile("" ::: "memory");
        ATT_DMA(t + 2 < nt ? t + 2 : nt - 1, bnxt);
        const LAS unsigned char* kb = F.lds + bcur * ATT_BUF; const LAS unsigned char* vb = kb + ATT_KB;
        f32x16 p[2];
#pragma unroll
        for (int hf = 0; hf < 2; ++hf) {
#pragma unroll
            for (int r = 0; r < 16; ++r) p[hf][r] = 0.f;
            const int kv = 32 * hf + r32; bf16x8 kf[8];
#pragma unroll
            for (int ds = 0; ds < 8; ++ds) kf[ds] = *(const LAS bf16x8*)(kb + (kv * 16 + ((2 * ds + hi) ^ (kv & 15))) * 16);
            __builtin_amdgcn_sched_barrier(0);
#pragma unroll
            for (int ds = 0; ds < 8; ++ds) p[hf] = __builtin_amdgcn_mfma_f32_32x32x16_bf16(kf[ds], qf[ds], p[hf], 0, 0, 0);
        }
        const int jt = t < nloc ? jl + t : -1;
        if (jt == 0 || jt == 4) {
#pragma unroll
            for (int hf = 0; hf < 2; ++hf)
#pragma unroll
                for (int r = 0; r < 16; ++r) { const int kvi = 32 * hf + crow(r, hi); const bool ok = jt == 0 ? (kvi >= qi) : (kvi <= qi); if (!ok) p[hf][r] = -1e30f; }
        }
        float tm = p[0][0];
#pragma unroll
        for (int hf = 0; hf < 2; ++hf)
#pragma unroll
            for (int r = 0; r < 16; ++r) tm = fmaxf(tm, p[hf][r]);
        tm = fmaxf(tm, __shfl_xor(tm, 32));
        const float mnew = fmaxf(mrun, tm), sc = __builtin_amdgcn_exp2f(mrun - mnew);
        mrun = mnew; lrun *= sc;
#pragma unroll
        for (int d = 0; d < 4; ++d)
#pragma unroll
            for (int r = 0; r < 16; ++r) o[d][r] *= sc;
        float ls = 0.f;
#pragma unroll
        for (int hf = 0; hf < 2; ++hf)
#pragma unroll
            for (int r = 0; r < 16; ++r) { const float e = __builtin_amdgcn_exp2f(p[hf][r] - mnew); p[hf][r] = e; ls += e; }
        lrun += ls;
#pragma unroll
        for (int s = 0; s < 4; ++s) {
            const int hf = s >> 1, rb = 8 * (s & 1);
            u32x4 pw; pw.x = cvtpk_s(p[hf][rb + 0], p[hf][rb + 1]); pw.y = cvtpk_s(p[hf][rb + 2], p[hf][rb + 3]); pw.z = cvtpk_s(p[hf][rb + 4], p[hf][rb + 5]); pw.w = cvtpk_s(p[hf][rb + 6], p[hf][rb + 7]);
            const bf16x8 pf = __builtin_bit_cast(bf16x8, pw);
            u32x4 vw[4];
#pragma unroll
            for (int db = 0; db < 4; ++db) { const int d = 32 * db + r32; const int sw = (d >> 1) & 7;
                const int ua = 4 * s + hi, ub = 4 * s + 2 + hi;
                const u32x2 va = *(const LAS u32x2*)(vb + (d * 8 + ((ua >> 1) ^ sw)) * 16 + (ua & 1) * 8);
                const u32x2 vc = *(const LAS u32x2*)(vb + (d * 8 + ((ub >> 1) ^ sw)) * 16 + (ub & 1) * 8);
                vw[db].x = va.x; vw[db].y = va.y; vw[db].z = vc.x; vw[db].w = vc.y; }
            __builtin_amdgcn_sched_barrier(0);
#pragma unroll
            for (int db = 0; db < 4; ++db) o[db] = __builtin_amdgcn_mfma_f32_32x32x16_bf16(__builtin_bit_cast(bf16x8, vw[db]), pf, o[db], 0, 0, 0);
        }
        bcur = bcur == ATT_NB - 1 ? 0 : bcur + 1; bnxt = bnxt == ATT_NB - 1 ? 0 : bnxt + 1;
    }
    asm volatile("s_waitcnt lgkmcnt(0)" ::: "memory"); __builtin_amdgcn_s_barrier(); asm volatile("" ::: "memory");
    const float ltot = lrun + __shfl_xor(lrun, 32); const float inv = 1.0f / ltot;
    bf16_t* op = ATT + (size_t)qrow * D + head * 128;
#pragma unroll
    for (int db = 0; db < 4; ++db)
#pragma unroll
        for (int g = 0; g < 4; ++g) { u32x2 w; w.x = cvtpk_s(o[db][4 * g] * inv, o[db][4 * g + 1] * inv); w.y = cvtpk_s(o[db][4 * g + 2] * inv, o[db][4 * g + 3] * inv);
            *(u32x2*)(op + 32 * db + 8 * g + 4 * hi) = w; }
#undef ATT_DMA
}
__device__ __forceinline__ void phase_attn(Frame& F, int j, bool ctx_out) {
    relaunder(F);
    const float* sink = ((const float*)(GAS const float*)F.kp[I_SINK]) + j * 16;
    const int nunits = 1024 + (ctx_out ? 64 : 0);
    for (int u = F.cu; u < nunits; u += F.G) {
        if (u < 1024) { const int b = u >> 8, kvh = (u >> 6) & 3, qb = u & 63; attn_unit(F, b, kvh, b * SEQ + 64 * qb, false, 64 * qb, sink); }
        else { const int v = u - 1024, b = v >> 4, kvh = (v >> 2) & 3, qc = v & 3; attn_unit(F, b, kvh, ML + b * CTXL + 64 * qc, true, 0, sink); }
    }
}

#ifndef MK_PER_PHASE
#define MK_PER_PHASE 0
#endif
constexpr int NPHASE = 2 + 10 * DEPTH;
#ifndef EN
#define EN 0xffff
#endif
#ifndef DUP
#define DUP 0
#endif
struct Args { const float* in[25]; float* out; unsigned char* ws; int ph_lo, ph_hi; };
__global__ void __launch_bounds__(NWAVES * 64, 2) fwd_kernel(Args args) {
    extern __shared__ __attribute__((aligned(16))) unsigned char lds[];
    Frame F;
    F.lds = (LAS unsigned char*)lds;
    F.tid = threadIdx.x; F.lane = F.tid & 63; F.wave = __builtin_amdgcn_readfirstlane(F.tid >> 6);
    F.G = gridDim.x; F.gw = blockIdx.x * NWAVES + F.wave; F.ngw = F.G * NWAVES;
    F.kp = kargs(); F.ws = (unsigned char*)(GAS unsigned char*)F.kp[26]; F.cu = blockIdx.x;
    volatile LAS unsigned* MISC = (volatile LAS unsigned*)(F.lds + MISC_OFF);
    for (int u = F.tid; u < (LDS_BYTES - LDSCTL_OFF) / 4; u += NWAVES * 64) ((LAS unsigned*)(F.lds + LDSCTL_OFF))[u] = 0u;
    __syncthreads();
    XcdBarrier bar = xcd_barrier_post((unsigned*)(F.ws + WS_CTL) + CW_BAR, MISC + 8);
#if MK_PER_PHASE
    const int lo = (int)(unsigned)F.kp[27], hi = (int)(unsigned)(F.kp[27] >> 32);
#define IN(k) (lo <= (k) && (k) < hi)
#define SEAM() do { } while (0)
#else
#define IN(k) true
#define SEAM() do { XcdBarrier b2_; b2_.bar = (unsigned*)(F.ws + WS_CTL) + CW_BAR; b2_.x = xb_xcc_id(); b2_.st = MISC + 8; xcd_barrier(b2_); } while (0)
#endif
#define modv ((float*)(F.ws + WS_MODV))
#define U ((bf16_t*)(F.ws + WS_U))
#define BIG ((bf16_t*)(F.ws + WS_BIG))
#define HA ((float*)(F.ws + WS_HA))
#define cu (F.cu)
#define modL (modv + (size_t)L * 5 * MODN)

    if (IN(0)) { if (EN&1) phase_p0a(F); if (DUP&1) { __syncthreads(); phase_p0a(F); } SEAM(); }
    if (IN(1)) { if (EN&2) phase_rows<0>(F, MT, nullptr, nullptr, modv, 0, D); SEAM(); }
    for (int L = 0; L < DEPTH; ++L) {
        const int base = 2 + 10 * L, j = L >> 1; const bool last = (L == DEPTH - 1), rec = (L & 1) == 0; const int Mrows = last ? ML : MT;
        if (IN(base + 0)) {
            if (rec) { if (EN&4) { relaunder(F);
                pg8::Gemm g{U, (const bf16_t*)(F.ws + WS_WIN) + (size_t)j * FF * D, MT, FF, D}; pg8::StaticOrder S; S.init(MT, FF, F.G, cu);
                pg8::EpiBf16 E{BIG, FF, 11};
                pg8::gemm_phase<pg8::EpiBf16, pg8::StaticOrder, PG8_ALIGN, PG8_SP2>(F.lds + RING_OFF, g, S, E); }
            } else {
                if (EN&8) { relaunder(F); const bf16_t* Wq = (const bf16_t*)(F.ws + WS_WQKV) + (size_t)j * NQKV * D; pg8::Gemm g{U, Wq, MT, NQK, D}; pg8::StaticOrder S; S.init(MT, NQK, F.G, cu);
                  pg8::EpiQK E{BIG, (const f32x2*)(F.ws + WS_ROPE)};
                  pg8::gemm_phase<pg8::EpiQK, pg8::StaticOrder, PG8_ALIGN, PG8_SP2>(F.lds + RING_OFF, g, S, E); }
                if (EN&16) { relaunder(F); const bf16_t* Wq = (const bf16_t*)(F.ws + WS_WQKV) + (size_t)j * NQKV * D; pg8::Gemm g{Wq + (size_t)NQK * D, U, NVV, MT, D}; pg8::StaticOrder S; S.init(NVV, MT, F.G, (cu + 88) & 255);
                  pg8::EpiBf16 E{(bf16_t*)(F.ws + WS_HF), MT, 0};
                  pg8::gemm_phase<pg8::EpiBf16, pg8::StaticOrder, PG8_ALIGN, PG8_SP2>(F.lds + RING_OFF, g, S, E); }
            }
            SEAM();
        }
        if (rec) {
            if (IN(base + 1)) { if (EN&32) phase_conv(F, j); if (DUP&32) phase_conv(F, j); SEAM(); }
            if (IN(base + 2)) { if (EN&64) phase_scan(F, j); if (DUP&64) phase_scan(F, j); SEAM(); }
        } else {
            if (IN(base + 2)) { for (int rep = 0; rep < ((DUP&128) ? 2 : 1); ++rep) { if (EN&128) phase_attn(F, j, !last); } SEAM(); }
        }
        if (IN(base + 3)) { if (EN&256) { relaunder(F);
            pg8::Gemm g; if (rec) g = pg8::Gemm{(const bf16_t*)(F.ws + WS_V), (const bf16_t*)(F.ws + WS_WOUT) + (size_t)j * D * DR, Mrows, D, DR};
            else g = pg8::Gemm{(const bf16_t*)(F.ws + WS_Z), (const bf16_t*)(F.ws + WS_WO) + (size_t)j * D * D, Mrows, D, D};
            pg8::TailOrder S; S.init(D, g.K, F.G, cu, !last);
            const float* st_ = (const float*)(F.ws + WS_STATS);
            pg8::EpiRes E{HA, D, modL + 2 * D, MODN, (float*)(F.ws + WS_SLAB), L == 0 ? (const float*)(GAS const float*)F.kp[I_X] : (const float*)HA, L == 0 ? nullptr : st_,
                          ((const float*)(GAS const float*)F.kp[I_LNFG]) + (size_t)(L > 0 ? L - 1 : 0) * D, ((const float*)(GAS const float*)F.kp[I_LNFB]) + (size_t)(L > 0 ? L - 1 : 0) * D};
            pg8::gemm_phase<pg8::EpiRes, pg8::TailOrder, PG8_ALIGN, PG8_SP2>(F.lds + RING_OFF, g, S, E); }
            SEAM();
        }
        if (IN(base + 4)) { if (EN&512) phase_rows<1>(F, Mrows, ((const float*)(GAS const float*)F.kp[I_LNMG]) + (size_t)L * D, ((const float*)(GAS const float*)F.kp[I_LNMB]) + (size_t)L * D, modL, 3 * D, 4 * D, last ? nullptr : (const float*)(F.ws + WS_SLAB), modL + 4 * MODN + 2 * D); SEAM(); }
        if (IN(base + 5)) { if (EN&1024) { relaunder(F);
            pg8::Gemm g{U, (const bf16_t*)(F.ws + WS_WGU) + (size_t)L * (2 * FF) * D, Mrows, 2 * FF, D}; pg8::StaticOrder S; S.init(Mrows, 2 * FF, F.G, cu);
            pg8::EpiGU E{BIG, FF};
            pg8::gemm_phase<pg8::EpiGU, pg8::StaticOrder, PG8_ALIGN, PG8_SP2>(F.lds + RING_OFF, g, S, E); }
            SEAM();
        }
        if (IN(base + 6)) { if (EN&2048) { relaunder(F);
            pg8::Gemm g{BIG, (const bf16_t*)(F.ws + WS_WD) + (size_t)L * D * FF, Mrows, D, FF}; pg8::TailOrder S; S.init(D, FF, F.G, cu, !last);
            pg8::EpiRes E{HA, D, modL + 5 * D, MODN, (float*)(F.ws + WS_SLAB), (const float*)HA, (const float*)(F.ws + WS_STATS),
                          ((const float*)(GAS const float*)F.kp[I_LNMG]) + (size_t)L * D, ((const float*)(GAS const float*)F.kp[I_LNMB]) + (size_t)L * D};
            pg8::gemm_phase<pg8::EpiRes, pg8::TailOrder, PG8_ALIGN, PG8_SP2>(F.lds + RING_OFF, g, S, E); }
            SEAM();
        }
        if (IN(base + 7)) { if (EN&4096) {
            if (last) phase_rows<2>(F, ML, ((const float*)(GAS const float*)F.kp[I_LNFG]) + (size_t)L * D, ((const float*)(GAS const float*)F.kp[I_LNFB]) + (size_t)L * D, nullptr, 0, 0);
            else { phase_rows<1>(F, MT, ((const float*)(GAS const float*)F.kp[I_LNFG]) + (size_t)L * D, ((const float*)(GAS const float*)F.kp[I_LNFB]) + (size_t)L * D, modv + (size_t)(L + 1) * 5 * MODN, 0, D, (const float*)(F.ws + WS_SLAB), modL + 4 * MODN + 5 * D); } }
            if (!last) SEAM();
        }
    }
#undef IN
#undef SEAM
#undef modv
#undef U
#undef BIG
#undef HA
#undef cu
#undef modL
}

extern "C" void kernel_launch(void* const* d_in, const int* in_sizes, int n_in, void* d_out, int out_size, void* d_ws, size_t ws_size, hipStream_t stream) {
    static int grid = 0;
    if (grid == 0) {
        if (n_in != 25 || out_size != ML * D || ws_size < WS_END) { fprintf(stderr, "kernel_launch: unexpected shapes / workspace (n_in %d out %d ws %zu need %zu)\n", n_in, out_size, ws_size, (size_t)WS_END); grid = -1; return; }
        int dev = 0, cus = 0;
        if (hipGetDevice(&dev) != hipSuccess || hipDeviceGetAttribute(&cus, hipDeviceAttributeMultiprocessorCount, dev) != hipSuccess) { grid = -1; return; }
        if (hipFuncSetAttribute((const void*)fwd_kernel, hipFuncAttributeMaxDynamicSharedMemorySize, LDS_BYTES) != hipSuccess) { fprintf(stderr, "kernel_launch: hipFuncSetAttribute failed\n"); grid = -1; return; }
        int per_cu = 0;
        if (hipOccupancyMaxActiveBlocksPerMultiprocessor(&per_cu, (const void*)fwd_kernel, NWAVES * 64, LDS_BYTES) != hipSuccess || per_cu < 1) { fprintf(stderr, "kernel_launch: occupancy query says %d\n", per_cu); }
        (void)hipGetLastError();
        grid = cus < 256 ? cus : 256;
    }
    if (grid < 0) return;
    if (hipMemsetAsync((char*)d_ws + WS_CTL, 0, CTL_ZERO_BYTES, stream) != hipSuccess) return;
    Args a{};
    for (int i = 0; i < 25; ++i) a.in[i] = (const float*)d_in[i];
    a.out = (float*)d_out; a.ws = (unsigned char*)d_ws;
#if MK_PER_PHASE
    for (int p = 0; p < NPHASE; ++p) { a.ph_lo = p; a.ph_hi = p + 1; hipLaunchKernelGGL(fwd_kernel, dim3(grid), dim3(NWAVES * 64), LDS_BYTES, stream, a); }
#else
    a.ph_lo = 0; a.ph_hi = NPHASE;
    hipLaunchKernelGGL(fwd_kernel, dim3(grid), dim3(NWAVES * 64), LDS_BYTES, stream, a);
#endif
    const hipError_t le = hipPeekAtLastError();
    if (le != hipSuccess) fprintf(stderr, "kernel_launch: launch failed: %s\n", hipGetErrorName(le));
}
```
